# Optimizing an MI355X kernel written in HIP

```python
import jax, jax.numpy as jnp
from jax import lax
import numpy as np

D_MODEL = 1024
BATCH = 32
SEQ = 2048
DEPTH = 4
DEC_BATCH = 4
DEC_SEQ = 4096
PAST_LEN = 128

N_HEADS = 8
QK_NOPE = 128
QK_ROPE = 64
V_HEAD = 128
Q_LORA = 512
KV_LORA = 256
ATTN_WIDTH = N_HEADS * V_HEAD
QK_HEAD = QK_NOPE + QK_ROPE
ROPE_BASE = 10000.0
Q_BLOCK = 128
N_FOURIER_GROUPS = 4
FOURIER_GROUP = 128
FOURIER_WIDTH = N_FOURIER_GROUPS * FOURIER_GROUP
D_FF = 2816
CONV_WIDTH = 3
EPS = 1e-6
N_ADA = 6
OFF_Q = 0
OFF_KV = OFF_Q + Q_LORA
OFF_KR = OFF_KV + KV_LORA
OFF_F = OFF_KR + QK_ROPE
OFF_G = OFF_F + FOURIER_WIDTH
IN_WIDTH = OFF_G + 2 * D_MODEL

kernel_name = 'hybrid_mla_fnet_convffn_encoder'


def rms_norm(x, g):
    xf = x.astype(jnp.float32)
    y = xf * lax.rsqrt(jnp.mean(xf * xf, axis=-1, keepdims=True) + EPS)
    return (y * g.astype(jnp.float32)).astype(x.dtype)


def rope_tables(seq_len):
    half = QK_ROPE // 2
    inv = 1.0 / (ROPE_BASE ** (jnp.arange(half, dtype=jnp.float32) / half))
    ang = jnp.arange(seq_len, dtype=jnp.float32)[:, None] * inv[None, :]
    return jnp.cos(ang), jnp.sin(ang)


def apply_rope(x, cos, sin):
    x1, x2 = jnp.split(x.astype(jnp.float32), 2, axis=-1)
    c = cos[None, :, None, :]
    s = sin[None, :, None, :]
    return jnp.concatenate([x1 * c - x2 * s, x2 * c + x1 * s], axis=-1).astype(x.dtype)


def bidir_attention(q, k, v):
    B, S, H, Dq = q.shape
    nb = S // Q_BLOCK
    scale = Dq ** -0.5
    qb = q.reshape(B, nb, Q_BLOCK, H, Dq).transpose(1, 0, 2, 3, 4)

    def block(qi):
        s = jnp.einsum('bqhd,bkhd->bhqk', qi, k).astype(jnp.float32) * scale
        p = jax.nn.softmax(s, axis=-1).astype(v.dtype)
        return jnp.einsum('bhqk,bkhd->bqhd', p, v)

    o = lax.map(block, qb)
    return o.transpose(1, 0, 2, 3, 4).reshape(B, S, H * v.shape[-1])


def fourier_mix(u):
    B, S, _ = u.shape
    ug = u.reshape(B, S, N_FOURIER_GROUPS, FOURIER_GROUP).astype(jnp.float32)
    f = jnp.fft.fft2(ug, axes=(1, 3), norm='ortho').real
    return f.reshape(B, S, FOURIER_WIDTH).astype(u.dtype)


def centred_dwconv(h, w, b):
    S = h.shape[1]
    hp = jnp.pad(h, ((0, 0), (1, 1), (0, 0)))
    return hp[:, :S] * w[0] + hp[:, 1:S + 1] * w[1] + hp[:, 2:] * w[2] + b


def mixer_block(h, cos, sin, w_in, g_q, w_q_b, g_kv, w_kv_b, w_attn_o, w_four, w_out):
    B, S, _ = h.shape
    z = h @ w_in
    c_q = rms_norm(z[..., OFF_Q:OFF_KV], g_q)
    c_kv = rms_norm(z[..., OFF_KV:OFF_KR], g_kv)
    k_rope = z[..., OFF_KR:OFF_F].reshape(B, S, 1, QK_ROPE)
    u_f = z[..., OFF_F:OFF_G]
    gate_a, gate_b = jnp.split(z[..., OFF_G:], 2, axis=-1)

    q = (c_q @ w_q_b).reshape(B, S, N_HEADS, QK_HEAD)
    q = jnp.concatenate([q[..., :QK_NOPE], apply_rope(q[..., QK_NOPE:], cos, sin)], axis=-1)
    kv = (c_kv @ w_kv_b).reshape(B, S, N_HEADS, QK_NOPE + V_HEAD)
    k_nope, v = kv[..., :QK_NOPE], kv[..., QK_NOPE:]
    k_rope = jnp.broadcast_to(apply_rope(k_rope, cos, sin), (B, S, N_HEADS, QK_ROPE))
    k = jnp.concatenate([k_nope, k_rope], axis=-1)

    branch_a = bidir_attention(q, k, v) @ w_attn_o
    branch_b = fourier_mix(u_f) @ w_four
    merged = jax.nn.sigmoid(gate_a) * branch_a + jax.nn.sigmoid(gate_b) * branch_b
    return merged @ w_out


def conv_ffn(h, w_up, w_conv, b_conv, w_down):
    up = centred_dwconv(h @ w_up, w_conv, b_conv)
    a, b = jnp.split(up, 2, axis=-1)
    return (jax.nn.gelu(a, approximate=True) * b) @ w_down


def trunk(x, c, w_ada, b_ada, g_mix_pre, g_mix_post, w_in, g_q, w_q_b, g_kv, w_kv_b,
          w_attn_o, w_four, w_out, g_ffn_pre, g_ffn_post, w_up, w_conv, b_conv, w_down):
    cos, sin = rope_tables(x.shape[1])
    for l in range(DEPTH):
        mod = jax.nn.silu(c) @ w_ada[l] + b_ada[l]
        sh1, sc1, gt1, sh2, sc2, gt2 = [m[:, None, :] for m in jnp.split(mod, N_ADA, axis=-1)]
        h = rms_norm(x, g_mix_pre[l]) * (1 + sc1) + sh1
        y = mixer_block(h, cos, sin, w_in[l], g_q[l], w_q_b[l], g_kv[l], w_kv_b[l],
                        w_attn_o[l], w_four[l], w_out[l])
        x = x + gt1 * rms_norm(y, g_mix_post[l])
        h = rms_norm(x, g_ffn_pre[l]) * (1 + sc2) + sh2
        y = conv_ffn(h, w_up[l], w_conv[l], b_conv[l], w_down[l])
        x = x + gt2 * rms_norm(y, g_ffn_post[l])
    return x


def setup_inputs(seed: int = 0) -> dict:
    key = jax.random.key(seed)
    ks = jax.random.split(key, 24)
    f32 = jnp.float32

    def dense(k, fan_in, fan_out, scale=1.0):
        return jax.random.normal(k, (DEPTH, fan_in, fan_out), f32) * (scale * fan_in ** -0.5)

    def gain(k, dim):
        return 1.0 + 0.02 * jax.random.normal(k, (DEPTH, dim), f32)

    return {
        'x_prompt': jax.random.normal(ks[0], (BATCH, SEQ, D_MODEL), f32),
        'x_sample': jax.random.normal(ks[1], (DEC_BATCH, DEC_SEQ, D_MODEL), f32),
        'c_prompt': jax.random.normal(ks[2], (BATCH, D_MODEL), f32),
        'c_sample': jax.random.normal(ks[3], (DEC_BATCH, D_MODEL), f32),
        'w_ada': dense(ks[4], D_MODEL, N_ADA * D_MODEL, 0.5),
        'b_ada': 0.02 * jax.random.normal(ks[5], (DEPTH, N_ADA * D_MODEL), f32),
        'g_mix_pre': gain(ks[6], D_MODEL),
        'g_mix_post': gain(ks[7], D_MODEL),
        'w_in': dense(ks[8], D_MODEL, IN_WIDTH),
        'g_q': gain(ks[9], Q_LORA),
        'w_q_b': dense(ks[10], Q_LORA, N_HEADS * QK_HEAD),
        'g_kv': gain(ks[11], KV_LORA),
        'w_kv_b': dense(ks[12], KV_LORA, N_HEADS * (QK_NOPE + V_HEAD)),
        'w_attn_o': dense(ks[13], ATTN_WIDTH, D_MODEL),
        'w_four': dense(ks[14], FOURIER_WIDTH, D_MODEL),
        'w_out': dense(ks[15], D_MODEL, D_MODEL),
        'g_ffn_pre': gain(ks[16], D_MODEL),
        'g_ffn_post': gain(ks[17], D_MODEL),
        'w_up': dense(ks[18], D_MODEL, 2 * D_FF),
        'w_conv': jax.random.normal(ks[19], (DEPTH, CONV_WIDTH, 2 * D_FF), f32) * (CONV_WIDTH ** -0.5),
        'b_conv': 0.02 * jax.random.normal(ks[20], (DEPTH, 2 * D_FF), f32),
        'w_down': dense(ks[21], D_FF, D_MODEL),
    }


def reference(x_prompt, x_sample, c_prompt, c_sample, w_ada, b_ada, g_mix_pre, g_mix_post,
              w_in, g_q, w_q_b, g_kv, w_kv_b, w_attn_o, w_four, w_out, g_ffn_pre, g_ffn_post,
              w_up, w_conv, b_conv, w_down):
    y_prompt = trunk(x_prompt, c_prompt, w_ada, b_ada, g_mix_pre, g_mix_post, w_in, g_q, w_q_b,
                     g_kv, w_kv_b, w_attn_o, w_four, w_out, g_ffn_pre, g_ffn_post,
                     w_up, w_conv, b_conv, w_down)
    y_sample = trunk(x_sample, c_sample, w_ada, b_ada, g_mix_pre, g_mix_post, w_in, g_q, w_q_b,
                     g_kv, w_kv_b, w_attn_o, w_four, w_out, g_ffn_pre, g_ffn_post,
                     w_up, w_conv, b_conv, w_down)
    return (y_prompt, y_sample)
```

```cpp
#include <hip/hip_runtime.h>
#include <hip/hip_cooperative_groups.h>
#include <cstdio>
#include <cstdint>
namespace cg = cooperative_groups;

#define LAS __attribute__((address_space(3)))
typedef unsigned short bf16_t;
typedef short bf16x8 __attribute__((ext_vector_type(8)));
typedef short s16x4 __attribute__((ext_vector_type(4)));
typedef float f32x4 __attribute__((ext_vector_type(4)));
typedef float f32x2 __attribute__((ext_vector_type(2)));
typedef float f32x16 __attribute__((ext_vector_type(16)));
typedef unsigned u32x4 __attribute__((ext_vector_type(4)));
typedef unsigned u32x2 __attribute__((ext_vector_type(2)));

constexpr int DM = 1024, DEPTH = 4, NB_ALL = 36;
constexpr int INW = 3392, OFF_KR = 768, OFF_F = 832, OFF_G = 1344;
constexpr int NZ1 = 3072, NQ = 1536, NKV = 2048, DFF = 2816, NUP = 5632;
constexpr int T = 16384, NCHUNK = 5;
constexpr float EPS = 1e-6f;

constexpr size_t MiB = 1u << 20;
constexpr size_t WS_ROPE = 1 * MiB;
constexpr size_t WS_MOD = 2 * MiB;
constexpr size_t WS_RQ = 6 * MiB;
constexpr size_t WS_RKV = 6 * MiB + 256 * 1024;
constexpr size_t WS_W = 8 * MiB;
constexpr size_t WS_D2 = 136 * MiB;
constexpr size_t WS_D4 = 152 * MiB;
constexpr size_t WS_H = 216 * MiB;
constexpr size_t WS_Z1 = 248 * MiB;
constexpr size_t WS_UT = 344 * MiB;
constexpr size_t WS_Q = 376 * MiB;
constexpr size_t WS_UP = 248 * MiB;
constexpr size_t WS_KV = 424 * MiB;
constexpr size_t WS_KR = 488 * MiB;
constexpr size_t WS_AO = 490 * MiB;
constexpr size_t WS_FO = 522 * MiB;
constexpr size_t WS_MG = 538 * MiB;
constexpr size_t WS_Y = 570 * MiB;
constexpr size_t WS_ACT = 602 * MiB;
constexpr size_t WS_END = 690 * MiB;
constexpr size_t W_IN = 0, W_F = 3145728, W_QB = 4194304, W_KVB = 4980736, W_AO = 5505024, W_FOUR = 6553600, W_OUT = 7077888, W_UP = 8126464, W_DOWN = 13893632, W_LAYER = 16777216;

constexpr int LDS_BYTES = 135168;

__device__ __forceinline__ unsigned f2bf(float f) { unsigned u = __builtin_bit_cast(unsigned, f); return (u + 0x7fffu + ((u >> 16) & 1u)) >> 16; }
__device__ __forceinline__ unsigned pk2(float lo, float hi) { return f2bf(lo) | (f2bf(hi) << 16); }
__device__ __forceinline__ float bf_lo(unsigned w) { return __builtin_bit_cast(float, w << 16); }
__device__ __forceinline__ float bf_hi(unsigned w) { return __builtin_bit_cast(float, w & 0xffff0000u); }
__device__ __forceinline__ unsigned cvt_pk_bf16(float lo, float hi) { unsigned r; asm volatile("v_cvt_pk_bf16_f32 %0, %1, %2" : "=v"(r) : "v"(lo), "v"(hi)); return r; }
__device__ __forceinline__ float wave_sum(float v) {
#pragma unroll
    for (int o = 1; o < 64; o <<= 1) v += __shfl_xor(v, o);
    return v;
}
__device__ __forceinline__ float sigmoidf_(float x) { return __fdividef(1.f, 1.f + __expf(-x)); }

namespace pg8 {
constexpr int BM = 256, BK = 64, HALF = 128, HTB = HALF * BK * 2, STAGE_BYTES = 8 * HTB, NXCD = 8, WGM = 8;
__host__ __device__ __forceinline__ int lds_byte(int r, int c) { const int st = (r >> 4) * 2 + (c >> 5), rr = r & 15, cc = c & 31, ob = rr * 64 + cc * 2; return st * 1024 + (ob ^ (((ob >> 9) & 1) << 5)); }
__host__ __device__ __forceinline__ void stage_rc(int b, int& R, int& C) { const int st = b / 1024, sb = b % 1024, swz = sb ^ (((sb >> 9) & 1) << 5); R = (st >> 1) * 16 + swz / 64; C = (st & 1) * 32 + (swz % 64) / 2; }
__host__ __device__ __forceinline__ int perm32(int rho) { const int n = rho >> 4, i = rho & 15; return 8 * (i >> 2) + 4 * n + (i & 3); }

struct Unit { int pm, pn, bz; };
struct Gemm { const bf16_t* A; const bf16_t* Bt; int K, lda, ldb; size_t bsA, bsB; };

struct StaticOrder {
    int nM, nN, nwg, G, c;
    __device__ void init(int M, int N, int G_, int c_) { nM = M / BM; nN = N / BM; nwg = nM * nN; G = G_; c = c_; }
    __device__ bool next(int i, Unit& u) const {
        const long L = (long)i * G + c; if (L >= nwg) return false;
        int wgid = (int)L; { const int q = nwg / NXCD, r = nwg % NXCD, xcd = wgid % NXCD, off = wgid / NXCD; wgid = (xcd < r ? xcd * (q + 1) : r * (q + 1) + (xcd - r) * q) + off; }
        const int nig = WGM * nN, gid = wgid / nig, fm = gid * WGM, gsz = (nM - fm) < WGM ? (nM - fm) : WGM;
        u.pm = fm + ((wgid % nig) % gsz); u.pn = (wgid % nig) / gsz; u.bz = 0; return true;
    }
};
struct DftOrder {
    int first, step, count, nqb;
    __device__ bool next(int i, Unit& u) const {
        if (first < 0) return false; const int L = first + i * step; if (L >= count) return false;
        u.pn = L & 1; u.pm = (L >> 1) % nqb; u.bz = (L >> 1) / nqb; return true;
    }
};

template <class Epi, class Sched, bool ALIGN_EPI>
__device__ __forceinline__ void gemm_phase(LAS unsigned char* lds, const Gemm g, const Sched& S, const Epi& E) {
    int tid_ = threadIdx.x; asm volatile("" : "+v"(tid_));
    const int tid = tid_, wid = __builtin_amdgcn_readfirstlane(tid >> 6), lane = tid & 63, wr = wid >> 2, wc = wid & 3, fr = lane & 15, fq = lane >> 4;
    const int K = g.K, nt = K / BK;
    unsigned voffA[2], voffB[2];
#pragma unroll
    for (int i = 0; i < 2; ++i) { int R, C; stage_rc(tid * 16 + i * 8192, R, C); const int Rb = (R & ~31) + perm32(R & 31);
        voffA[i] = (unsigned)(R * g.lda + C) * 2u; voffB[i] = (unsigned)(Rb * g.ldb + C) * 2u; }
    const size_t kstep = (size_t)(BK * 2);
    const size_t hstepA = (size_t)HALF * g.lda * 2, hstepB = (size_t)HALF * g.ldb * 2;
    const size_t tstepA = 2 * hstepA, tstepB = 2 * hstepB;
    const unsigned ldsw = (unsigned)wid * 1024u;
    const int aoff = lds_byte(wr * 64 + fr, fq * 8), boff = lds_byte(wc * 32 + fr, fq * 8);
#define PG8_SA(b, h) (((b) * 2 + (h)) * HTB)
#define PG8_SB(b, h) ((4 + (b) * 2 + (h)) * HTB)
#define PG8_STAGE(bufoff, gbase, voff) do { _Pragma("unroll") for (int _i = 0; _i < 2; ++_i) \
        __builtin_amdgcn_global_load_lds((const unsigned*)((const char*)(gbase) + (voff)[_i]), (LAS unsigned*)(lds + (bufoff) + ldsw + _i * 8192), 16, 0, 0); } while (0)
#define PG8_LDA(dst, b, h) do { _Pragma("unroll") for (int m = 0; m < 4; ++m) _Pragma("unroll") for (int k = 0; k < 2; ++k) dst[m][k] = *(const LAS bf16x8*)(lds + PG8_SA(b, h) + aoff + m * 2048 + k * 1024); } while (0)
#define PG8_LDB(dst, b, h) do { _Pragma("unroll") for (int n = 0; n < 2; ++n) _Pragma("unroll") for (int k = 0; k < 2; ++k) dst[n][k] = *(const LAS bf16x8*)(lds + PG8_SB(b, h) + boff + n * 2048 + k * 1024); } while (0)
#define PG8_MMA(ai, bj, At, Bt) do { __builtin_amdgcn_s_setprio(1); _Pragma("unroll") for (int m = 0; m < 4; ++m) _Pragma("unroll") for (int n = 0; n < 2; ++n) _Pragma("unroll") for (int k = 0; k < 2; ++k) \
        acc[ai][bj][m][n] = __builtin_amdgcn_mfma_f32_16x16x32_bf16(Bt[n][k], At[m][k], acc[ai][bj][m][n], 0, 0, 0); __builtin_amdgcn_s_setprio(0); } while (0)
#define PG8_WAIT_V(n) asm volatile("s_waitcnt vmcnt(" #n ")" ::: "memory")
#define PG8_WAIT_L(n) asm volatile("s_waitcnt lgkmcnt(" #n ")" ::: "memory")
#define PG8_BAR __builtin_amdgcn_s_barrier()
#define PG8_SCHED __builtin_amdgcn_sched_barrier(0)
    Unit cur, nxt; int ui = 0;
    if (!S.next(0, cur)) return;
    f32x4 acc[2][2][4][2];
#pragma unroll
    for (int a = 0; a < 2; ++a)
#pragma unroll
        for (int b = 0; b < 2; ++b)
#pragma unroll
            for (int m = 0; m < 4; ++m)
#pragma unroll
                for (int n = 0; n < 2; ++n) acc[a][b][m][n] = (f32x4){0.f, 0.f, 0.f, 0.f};
    bf16x8 At[4][2], B0[2][2], B1[2][2];
    const char* cA = (const char*)g.A + (size_t)cur.bz * g.bsA * 2 + (size_t)cur.pm * tstepA;
    const char* cB = (const char*)g.Bt + (size_t)cur.bz * g.bsB * 2 + (size_t)cur.pn * tstepB;
    PG8_STAGE(PG8_SB(0, 0), cB, voffB); PG8_STAGE(PG8_SB(0, 1), cB + hstepB, voffB); PG8_STAGE(PG8_SA(0, 0), cA, voffA); PG8_STAGE(PG8_SA(0, 1), cA + hstepA, voffA);
    if (wr == 1) PG8_BAR;
    PG8_WAIT_V(2); PG8_BAR;
    PG8_STAGE(PG8_SB(1, 0), cB + kstep, voffB); PG8_STAGE(PG8_SA(1, 0), cA + kstep, voffA); PG8_STAGE(PG8_SB(1, 1), cB + hstepB + kstep, voffB);
    PG8_WAIT_V(6); PG8_BAR;
    for (;;) {
        const bool has_next = S.next(ui + 1, nxt);
        const char* nA = has_next ? (const char*)g.A + (size_t)nxt.bz * g.bsA * 2 + (size_t)nxt.pm * tstepA : cA;
        const char* nB = has_next ? (const char*)g.Bt + (size_t)nxt.bz * g.bsB * 2 + (size_t)nxt.pn * tstepB : cB;
        for (int t = 0; t < nt; t += 2) {
            const bool last = (t == nt - 2);
            const char* a1 = cA + (size_t)(t + 1) * kstep;
            const char* a2 = last ? nA : cA + (size_t)(t + 2) * kstep; const char* b2 = last ? nB : cB + (size_t)(t + 2) * kstep;
            const char* a3 = a2 + kstep; const char* b3 = b2 + kstep;
            PG8_LDB(B0, 0, 0); PG8_LDB(B1, 0, 1); PG8_SCHED; PG8_LDA(At, 0, 0); PG8_STAGE(PG8_SA(1, 1), a1 + hstepA, voffA);
            PG8_WAIT_V(8); PG8_WAIT_L(0); PG8_BAR; PG8_MMA(0, 0, At, B0); PG8_MMA(0, 1, At, B1); PG8_BAR; PG8_SCHED;
            PG8_LDA(At, 0, 1); PG8_STAGE(PG8_SB(0, 0), b2, voffB); PG8_STAGE(PG8_SB(0, 1), b2 + hstepB, voffB); PG8_STAGE(PG8_SA(0, 0), a2, voffA);
            PG8_WAIT_V(8); PG8_WAIT_L(0); PG8_BAR; PG8_MMA(1, 0, At, B0); PG8_MMA(1, 1, At, B1); PG8_BAR; PG8_SCHED;
            PG8_LDB(B0, 1, 0); PG8_LDB(B1, 1, 1); PG8_SCHED; PG8_LDA(At, 1, 0); PG8_STAGE(PG8_SA(0, 1), a2 + hstepA, voffA);
            PG8_WAIT_V(8); PG8_WAIT_L(0); PG8_BAR; PG8_MMA(0, 0, At, B0); PG8_MMA(0, 1, At, B1); PG8_BAR; PG8_SCHED;
            PG8_LDA(At, 1, 1); PG8_STAGE(PG8_SB(1, 0), b3, voffB); PG8_STAGE(PG8_SB(1, 1), b3 + hstepB, voffB); PG8_STAGE(PG8_SA(1, 0), a3, voffA);
            PG8_WAIT_V(8); PG8_WAIT_L(0); PG8_BAR; PG8_MMA(1, 0, At, B0); PG8_MMA(1, 1, At, B1); PG8_BAR; PG8_SCHED;
        }
        if constexpr (ALIGN_EPI) { if (wr == 0) PG8_BAR; }
        E(acc, cur, wr, wc, fr, fq);
        if (!has_next) break;
#pragma unroll
        for (int a = 0; a < 2; ++a)
#pragma unroll
            for (int b = 0; b < 2; ++b)
#pragma unroll
                for (int m = 0; m < 4; ++m)
#pragma unroll
                    for (int n = 0; n < 2; ++n) acc[a][b][m][n] = (f32x4){0.f, 0.f, 0.f, 0.f};
        cur = nxt; cA = nA; cB = nB; ++ui;
        if constexpr (ALIGN_EPI) { if (wr == 1) PG8_BAR; }
    }
    PG8_WAIT_V(0);
    if constexpr (!ALIGN_EPI) { if (wr == 0) PG8_BAR; }
    PG8_BAR;
#undef PG8_SA
#undef PG8_SB
#undef PG8_STAGE
#undef PG8_LDA
#undef PG8_LDB
#undef PG8_MMA
#undef PG8_WAIT_V
#undef PG8_WAIT_L
#undef PG8_BAR
#undef PG8_SCHED
}

typedef const f32x4 (&AccRef)[2][2][4][2];
#define EPI_ROWS for (int ai = 0; ai < 2; ++ai) for (int m = 0; m < 4; ++m)
__device__ __forceinline__ u32x4 pack8(f32x4 v0, f32x4 v1) { u32x4 w; w.x = cvt_pk_bf16(v0[0], v0[1]); w.y = cvt_pk_bf16(v0[2], v0[3]); w.z = cvt_pk_bf16(v1[0], v1[1]); w.w = cvt_pk_bf16(v1[2], v1[3]); return w; }
__device__ __forceinline__ void rope8(f32x4& v0, f32x4& v1, const float* cs) {
    const f32x4 t0 = *(const f32x4*)cs, t1 = *(const f32x4*)(cs + 4);
    f32x4 a = v0, b = v1;
    v0[0] = a[0] * t0[0] - a[1] * t0[1]; v0[1] = a[1] * t0[0] + a[0] * t0[1];
    v0[2] = a[2] * t0[2] - a[3] * t0[3]; v0[3] = a[3] * t0[2] + a[2] * t0[3];
    v1[0] = b[0] * t1[0] - b[1] * t1[1]; v1[1] = b[1] * t1[0] + b[0] * t1[1];
    v1[2] = b[2] * t1[2] - b[3] * t1[3]; v1[3] = b[3] * t1[2] + b[2] * t1[3];
}

struct EpiStore {
    bf16_t* O; int ldc;
    __device__ __forceinline__ void operator()(AccRef acc, const Unit& u, int wr, int wc, int fr, int fq) const {
        const int col0 = u.pn * BM + wc * 32 + 8 * fq;
#pragma unroll
        EPI_ROWS { const int row = u.pm * BM + ai * HALF + wr * 64 + m * 16 + fr; bf16_t* rowp = O + (size_t)row * ldc + col0;
#pragma unroll
            for (int bj = 0; bj < 2; ++bj) *(u32x4*)(rowp + bj * HALF) = pack8(acc[ai][bj][m][0], acc[ai][bj][m][1]); }
    }
};
struct EpiIn {
    bf16_t* Z1; bf16_t* KRb; float* rpart; const float* rope; int S;
    __device__ __forceinline__ void operator()(AccRef acc, const Unit& u, int wr, int wc, int fr, int fq) const {
        const int col0 = u.pn * BM + wc * 32 + 8 * fq;
        if (u.pn == 3) {
            if (wc < 2) {
#pragma unroll
                EPI_ROWS { const int row = u.pm * BM + ai * HALF + wr * 64 + m * 16 + fr; const int pos = row & (S - 1);
                    f32x4 v0 = acc[ai][0][m][0], v1 = acc[ai][0][m][1];
                    rope8(v0, v1, rope + ((size_t)pos * 32 + 16 * wc + 4 * fq) * 2);
                    *(u32x4*)(KRb + (size_t)row * 64 + 32 * wc + 8 * fq) = pack8(v0, v1); }
            }
            return;
        }
#pragma unroll
        EPI_ROWS { const int row = u.pm * BM + ai * HALF + wr * 64 + m * 16 + fr; bf16_t* rowp = Z1 + (size_t)row * NZ1 + col0;
            float s = 0.f;
#pragma unroll
            for (int bj = 0; bj < 2; ++bj) { const f32x4 v0 = acc[ai][bj][m][0], v1 = acc[ai][bj][m][1];
                s += (v0[0] * v0[0] + v0[1] * v0[1]) + (v0[2] * v0[2] + v0[3] * v0[3]) + (v1[0] * v1[0] + v1[1] * v1[1]) + (v1[2] * v1[2] + v1[3] * v1[3]);
                *(u32x4*)(rowp + bj * HALF) = pack8(v0, v1); }
            if (u.pn < 3) { s += __shfl_xor(s, 16); s += __shfl_xor(s, 32); if (fq == 0) rpart[(size_t)row * 12 + u.pn * 4 + wc] = s; }
        }
    }
};
struct EpiUT {
    bf16_t* UT; int S, lgS;
    __device__ __forceinline__ void operator()(AccRef acc, const Unit& u, int wr, int wc, int fr, int fq) const {
        const int col0 = u.pn * BM + wc * 32 + 8 * fq;
#pragma unroll
        EPI_ROWS { const int ch = u.pm * BM + ai * HALF + wr * 64 + m * 16 + fr;
#pragma unroll
            for (int bj = 0; bj < 2; ++bj) { const int tok = col0 + bj * HALF, b = tok >> lgS, pos = tok & (S - 1);
                *(u32x4*)(UT + ((size_t)(b * 512 + (ch & 511)) * 2 * S + (size_t)(ch >> 9) * S + pos)) = pack8(acc[ai][bj][m][0], acc[ai][bj][m][1]); } }
    }
};
struct EpiQ {
    bf16_t* Q; const float* rpart; const float* rope; int S;
    __device__ __forceinline__ void operator()(AccRef acc, const Unit& u, int wr, int wc, int fr, int fq) const {
        const int col0 = u.pn * BM + wc * 32 + 8 * fq;
#pragma unroll
        EPI_ROWS { const int row = u.pm * BM + ai * HALF + wr * 64 + m * 16 + fr; const int pos = row & (S - 1);
            const f32x4 p0 = *(const f32x4*)(rpart + (size_t)row * 12), p1 = *(const f32x4*)(rpart + (size_t)row * 12 + 4);
            const float r = __builtin_amdgcn_rsqf((((p0[0] + p0[1]) + (p0[2] + p0[3])) + ((p1[0] + p1[1]) + (p1[2] + p1[3]))) * (1.f / 512.f) + EPS);
#pragma unroll
            for (int bj = 0; bj < 2; ++bj) { const int col = col0 + bj * HALF, j = col % 192;
                f32x4 v0 = acc[ai][bj][m][0] * r, v1 = acc[ai][bj][m][1] * r;
                if (j >= 128) rope8(v0, v1, rope + ((size_t)pos * 32 + ((j - 128) >> 1)) * 2);
                *(u32x4*)(Q + (size_t)row * NQ + col) = pack8(v0, v1); } }
    }
};
struct EpiKV {
    bf16_t* KV; const float* rpart;
    __device__ __forceinline__ void operator()(AccRef acc, const Unit& u, int wr, int wc, int fr, int fq) const {
        const int col0 = u.pn * BM + wc * 32 + 8 * fq;
#pragma unroll
        EPI_ROWS { const int row = u.pm * BM + ai * HALF + wr * 64 + m * 16 + fr;
            const f32x4 p2 = *(const f32x4*)(rpart + (size_t)row * 12 + 8);
            const float r = __builtin_amdgcn_rsqf(((p2[0] + p2[1]) + (p2[2] + p2[3])) * (1.f / 256.f) + EPS);
#pragma unroll
            for (int bj = 0; bj < 2; ++bj) *(u32x4*)(KV + (size_t)row * NKV + col0 + bj * HALF) = pack8(acc[ai][bj][m][0] * r, acc[ai][bj][m][1] * r); }
    }
};
struct EpiDft {
    bf16_t* FO; int S; float scale;
    __device__ __forceinline__ void operator()(AccRef acc, const Unit& u, int wr, int wc, int fr, int fq) const {
        const int col0 = u.pn * BM + wc * 32 + 8 * fq;
#pragma unroll
        EPI_ROWS { const int row = u.bz * S + u.pm * BM + ai * HALF + wr * 64 + m * 16 + fr;
#pragma unroll
            for (int bj = 0; bj < 2; ++bj) *(u32x4*)(FO + (size_t)row * 512 + col0 + bj * HALF) = pack8(acc[ai][bj][m][0] * scale, acc[ai][bj][m][1] * scale); }
    }
};
template <bool ADD> struct EpiMerge {
    bf16_t* MG; const bf16_t* Z1; int goff;
    __device__ __forceinline__ void operator()(AccRef acc, const Unit& u, int wr, int wc, int fr, int fq) const {
        const int col0 = u.pn * BM + wc * 32 + 8 * fq;
#pragma unroll
        EPI_ROWS { const int row = u.pm * BM + ai * HALF + wr * 64 + m * 16 + fr;
#pragma unroll
            for (int bj = 0; bj < 2; ++bj) { const int col = col0 + bj * HALF;
                const u32x4 gw = *(const u32x4*)(Z1 + (size_t)row * NZ1 + goff + col);
                bf16_t* op = MG + (size_t)row * DM + col;
                f32x4 v0 = acc[ai][bj][m][0], v1 = acc[ai][bj][m][1];
                v0[0] *= sigmoidf_(bf_lo(gw.x)); v0[1] *= sigmoidf_(bf_hi(gw.x)); v0[2] *= sigmoidf_(bf_lo(gw.y)); v0[3] *= sigmoidf_(bf_hi(gw.y));
                v1[0] *= sigmoidf_(bf_lo(gw.z)); v1[1] *= sigmoidf_(bf_hi(gw.z)); v1[2] *= sigmoidf_(bf_lo(gw.w)); v1[3] *= sigmoidf_(bf_hi(gw.w));
                if (ADD) { const u32x4 pw = *(const u32x4*)op;
                    v0[0] += bf_lo(pw.x); v0[1] += bf_hi(pw.x); v0[2] += bf_lo(pw.y); v0[3] += bf_hi(pw.y);
                    v1[0] += bf_lo(pw.z); v1[1] += bf_hi(pw.z); v1[2] += bf_lo(pw.w); v1[3] += bf_hi(pw.w); }
                *(u32x4*)op = pack8(v0, v1); } }
    }
};
}

namespace att {
constexpr int NW = 8, QBLK = 32, KVBLK = 64;
constexpr float SCALE = 0.07216878364870322f;
constexpr float THR = 8.f;
constexpr int LDQ = NQ, LDK = NKV, LDKR = 64, LDO = DM;
constexpr int SHM_V = KVBLK * 128 * 2, SHM_K = KVBLK * 192 * 2, SHM_ATTN = 2 * SHM_V + 2 * SHM_K + NW * 64 * 4 + NW * 4096;
#define KSWZ(row, colB) ((row) * 384 + ((colB) ^ (((row) & 7) << 4)))
#define SBAR() __builtin_amdgcn_sched_barrier(0)
__device__ __forceinline__ int crow(int r, int hi) { return (r & 3) + 8 * (r >> 2) + 4 * hi; }
__device__ __forceinline__ unsigned cvtpk(float lo, float hi) { unsigned r; asm volatile("v_cvt_pk_bf16_f32 %0, %1, %2" : "=v"(r) : "v"(lo), "v"(hi)); return r; }
__device__ __forceinline__ bf16x8 ld8(const bf16_t* p) { return *reinterpret_cast<const bf16x8*>(p); }

__device__ __forceinline__ void partialSM(f32x16& p0, f32x16& p1, float& m_reg, float& mn, float& alpha) {
  constexpr float C = SCALE * 1.4426950408889634f;
  float pmax = p0[0];
#pragma unroll
  for (int r = 1; r < 16; ++r) pmax = fmaxf(pmax, p0[r]);
#pragma unroll
  for (int r = 0; r < 16; ++r) pmax = fmaxf(pmax, p1[r]);
  { auto rr = __builtin_amdgcn_permlane32_swap(__float_as_uint(pmax), __float_as_uint(pmax), false, false);
    pmax = fmaxf(__uint_as_float(rr[0]), __uint_as_float(rr[1])); }
  if (__builtin_expect(__all(pmax - m_reg <= THR / SCALE), 1)) { mn = m_reg; alpha = 1.f; }
  else { mn = fmaxf(m_reg, pmax); alpha = __builtin_amdgcn_exp2f((m_reg - mn) * C); m_reg = mn; }
  float mnC = -mn * C;
#pragma unroll
  for (int r = 0; r < 16; ++r) p0[r] = fmaf(p0[r], C, mnC);
#pragma unroll
  for (int r = 0; r < 16; ++r) p1[r] = fmaf(p1[r], C, mnC);
#pragma unroll
  for (int r = 0; r < 16; ++r) p0[r] = __builtin_amdgcn_exp2f(p0[r]);
}
__device__ __forceinline__ void finishSM(f32x16& p0, f32x16& p1, float alpha, float& l_reg, bf16x8& pa0, bf16x8& pa1, bf16x8& pa2, bf16x8& pa3) {
#pragma unroll
  for (int r = 0; r < 16; ++r) p1[r] = __builtin_amdgcn_exp2f(p1[r]);
  float ps = 0;
#pragma unroll
  for (int r = 0; r < 16; ++r) ps += p0[r];
#pragma unroll
  for (int r = 0; r < 16; ++r) ps += p1[r];
  { auto rr = __builtin_amdgcn_permlane32_swap(__float_as_uint(ps), __float_as_uint(ps), false, false);
    ps = __uint_as_float(rr[0]) + __uint_as_float(rr[1]); }
  l_reg = l_reg * alpha + ps;
#define PK4(P, BASE, OUT) do { unsigned a0 = cvtpk(P[BASE + 0], P[BASE + 1]), a1 = cvtpk(P[BASE + 2], P[BASE + 3]);   \
    unsigned b0 = cvtpk(P[BASE + 4], P[BASE + 5]), b1 = cvtpk(P[BASE + 6], P[BASE + 7]);                              \
    auto r0 = __builtin_amdgcn_permlane32_swap(a0, b0, false, false); auto r1 = __builtin_amdgcn_permlane32_swap(a1, b1, false, false); \
    u32x4 w = {r0[0], r1[0], r0[1], r1[1]}; OUT = *reinterpret_cast<bf16x8*>(&w); } while (0)
  PK4(p0, 0, pa0); PK4(p0, 8, pa1); PK4(p1, 0, pa2); PK4(p1, 8, pa3);
#undef PK4
}
__device__ __forceinline__ void qkt(f32x16& p0, f32x16& p1, const char* Ks, const bf16x8* qr, const char* qrl, int r32, int hi) {
  p0 = f32x16{}; p1 = f32x16{};
#pragma unroll
  for (int d0 = 0; d0 < 12; ++d0) { int cb = (d0 * 16 + hi * 8) * 2;
    bf16x8 b0 = *reinterpret_cast<const bf16x8*>(Ks + KSWZ(r32, cb));
    bf16x8 b1 = *reinterpret_cast<const bf16x8*>(Ks + KSWZ(32 + r32, cb));
    const bf16x8 qf = d0 < 8 ? qr[d0 & 7] : *reinterpret_cast<const bf16x8*>(qrl + (d0 - 8) * 1024);
    p0 = __builtin_amdgcn_mfma_f32_32x32x16_bf16(b0, qf, p0, 0, 0, 0);
    p1 = __builtin_amdgcn_mfma_f32_32x32x16_bf16(b1, qf, p1, 0, 0, 0); }
}
__device__ __forceinline__ int v_st(int k, int c) { const int kk = (k & ~0xC) | ((k & 4) << 1) | ((k & 8) >> 1); return ((kk >> 3) * 4 + (c >> 5)) * 512 + ((kk & 7) * 32 + (c & 31)) * 2; }
__device__ __forceinline__ int v_rd_base(int lane) { return ((lane & 3) << 3) | (((lane >> 2) & 3) << 6) | (((lane >> 4) & 1) << 5) | (((lane >> 5) & 1) << 8); }
constexpr int v_rd_off(int d0, int ks, int half) { return d0 * 512 + ks * 4096 + half * 2048; }
template <int OFF> __device__ __forceinline__ s16x4 tr_read(int vb) {
  s16x4 r; asm volatile("ds_read_b64_tr_b16 %0, %1 offset:%2" : "=&v"(r) : "v"(vb), "i"(OFF) : "memory"); return r;
}
template <int D0> __device__ __forceinline__ void pv_one(f32x16& od, int vb, bf16x8 pa0, bf16x8 pa1, bf16x8 pa2, bf16x8 pa3) {
  const s16x4 l0 = tr_read<v_rd_off(D0, 0, 0)>(vb), h0 = tr_read<v_rd_off(D0, 0, 1)>(vb), l1 = tr_read<v_rd_off(D0, 1, 0)>(vb), h1 = tr_read<v_rd_off(D0, 1, 1)>(vb);
  const s16x4 l2 = tr_read<v_rd_off(D0, 2, 0)>(vb), h2 = tr_read<v_rd_off(D0, 2, 1)>(vb), l3 = tr_read<v_rd_off(D0, 3, 0)>(vb), h3 = tr_read<v_rd_off(D0, 3, 1)>(vb);
  asm volatile("s_waitcnt lgkmcnt(0)" ::: "memory"); SBAR();
#define PK(L, H) (bf16x8){L[0], L[1], L[2], L[3], H[0], H[1], H[2], H[3]}
  od = __builtin_amdgcn_mfma_f32_32x32x16_bf16(pa0, PK(l0, h0), od, 0, 0, 0);
  od = __builtin_amdgcn_mfma_f32_32x32x16_bf16(pa1, PK(l1, h1), od, 0, 0, 0);
  od = __builtin_amdgcn_mfma_f32_32x32x16_bf16(pa2, PK(l2, h2), od, 0, 0, 0);
  od = __builtin_amdgcn_mfma_f32_32x32x16_bf16(pa3, PK(l3, h3), od, 0, 0, 0);
#undef PK
}
__device__ __forceinline__ void pv_d0(f32x16* o, int vb, bf16x8 pa0, bf16x8 pa1, bf16x8 pa2, bf16x8 pa3) {
  pv_one<0>(o[0], vb, pa0, pa1, pa2, pa3); pv_one<1>(o[1], vb, pa0, pa1, pa2, pa3); pv_one<2>(o[2], vb, pa0, pa1, pa2, pa3); pv_one<3>(o[3], vb, pa0, pa1, pa2, pa3);
}

__device__ __forceinline__ void attn_unit(const bf16_t* __restrict__ Qb, const bf16_t* __restrict__ Kh, const bf16_t* __restrict__ Vh, const bf16_t* __restrict__ Kr,
                                          bf16_t* __restrict__ Ob, int seq, char* lds) {
  int tid_ = threadIdx.x; asm volatile("" : "+v"(tid_));
  const int tid = tid_, wid = tid >> 6, lane = tid & 63, r32 = lane & 31, hi = lane >> 5;
  char* V_lds = lds; char* K_lds = lds + 2 * SHM_V;
  float* ws = (float*)(lds + 2 * SHM_V + 2 * SHM_K) + wid * 64; float* li_l = ws; float* al_l = ws + 32;
  float m_reg = -1e30f, l_reg = 0; f32x16 o[4] = {}; bf16x8 qr[8];
  char* qrl = lds + 2 * SHM_V + 2 * SHM_K + NW * 64 * 4 + wid * 4096 + lane * 16;
  const bf16_t* Qw = Qb + (long)(wid * QBLK + r32) * LDQ + hi * 8;
#pragma unroll
  for (int d0 = 0; d0 < 8; ++d0) qr[d0] = ld8(Qw + d0 * 16);
#pragma unroll
  for (int d0 = 8; d0 < 12; ++d0) *reinterpret_cast<bf16x8*>(qrl + (d0 - 8) * 1024) = ld8(Qw + d0 * 16);
  const int sr = tid >> 4, sc = (tid & 15) * 8, vst0 = v_st(sr, sc), vst1 = v_st(32 + sr, sc);
  const int krr = tid >> 3, krc = (tid & 7) * 8;
  const int vb0 = (int)(uintptr_t)V_lds + v_rd_base(lane);
  bf16x8 vs0, vs1, ks0, ks1, kr0;
#define SLOAD(k0) do { vs0 = ld8(&Vh[(long)((k0) + sr) * LDK + sc]); vs1 = ld8(&Vh[(long)((k0) + 32 + sr) * LDK + sc]); \
    ks0 = ld8(&Kh[(long)((k0) + sr) * LDK + sc]); ks1 = ld8(&Kh[(long)((k0) + 32 + sr) * LDK + sc]); kr0 = ld8(&Kr[(long)((k0) + krr) * LDKR + krc]); } while (0)
#define SWRITE(b) do { *(bf16x8*)(V_lds + (b) * SHM_V + vst0) = vs0; *(bf16x8*)(V_lds + (b) * SHM_V + vst1) = vs1; int kc = sc * 2; \
    *(bf16x8*)(K_lds + (b) * SHM_K + KSWZ(sr, kc)) = ks0; *(bf16x8*)(K_lds + (b) * SHM_K + KSWZ(32 + sr, kc)) = ks1; \
    *(bf16x8*)(K_lds + (b) * SHM_K + KSWZ(krr, 256 + krc * 2)) = kr0; } while (0)
#define SWAIT() asm volatile("s_waitcnt vmcnt(0)" ::: "memory")
#define RESC(a) do { if (__any((a) < 1.f)) { if (hi == 0) al_l[r32] = (a); asm volatile("s_waitcnt lgkmcnt(0)" ::: "memory"); \
    _Pragma("unroll") for (int d = 0; d < 4; ++d) _Pragma("unroll") for (int r = 0; r < 16; ++r) o[d][r] *= al_l[crow(r, hi)]; } } while (0)
  f32x16 pA0, pA1, pB0, pB1; float mnA, mnB, alA, alB; bf16x8 pa0, pa1, pa2, pa3; const int NT = seq / KVBLK;
  SLOAD(0); SWAIT(); SWRITE(0); __syncthreads();
  qkt(pA0, pA1, K_lds, qr, qrl, r32, hi); partialSM(pA0, pA1, m_reg, mnA, alA);
  SLOAD(KVBLK);
  SWAIT(); SWRITE(1); __syncthreads();
  for (int j = 1; j + 1 < NT; j += 2) {
    SBAR(); qkt(pB0, pB1, K_lds + SHM_K, qr, qrl, r32, hi);
    finishSM(pA0, pA1, alA, l_reg, pa0, pa1, pa2, pa3); SBAR();
    SLOAD((j + 1) * KVBLK); SBAR();
    pv_d0(o, vb0, pa0, pa1, pa2, pa3); partialSM(pB0, pB1, m_reg, mnB, alB);
    __syncthreads(); SWAIT(); SWRITE(0);
    RESC(alB); __syncthreads();
    SBAR(); qkt(pA0, pA1, K_lds, qr, qrl, r32, hi);
    finishSM(pB0, pB1, alB, l_reg, pa0, pa1, pa2, pa3); SBAR();
    SLOAD((j + 2) * KVBLK); SBAR();
    pv_d0(o, vb0 + SHM_V, pa0, pa1, pa2, pa3); partialSM(pA0, pA1, m_reg, mnA, alA);
    __syncthreads(); SWAIT(); SWRITE(1);
    RESC(alA); __syncthreads();
  }
  SBAR(); qkt(pB0, pB1, K_lds + SHM_K, qr, qrl, r32, hi);
  finishSM(pA0, pA1, alA, l_reg, pa0, pa1, pa2, pa3); SBAR();
  pv_d0(o, vb0, pa0, pa1, pa2, pa3); partialSM(pB0, pB1, m_reg, mnB, alB);
  __syncthreads(); RESC(alB);
  finishSM(pB0, pB1, alB, l_reg, pa0, pa1, pa2, pa3); SBAR();
  pv_d0(o, vb0 + SHM_V, pa0, pa1, pa2, pa3);
  if (hi == 0) li_l[r32] = l_reg; asm volatile("s_waitcnt lgkmcnt(0)" ::: "memory");
  float rli[16];
#pragma unroll
  for (int r = 0; r < 16; ++r) rli[r] = __builtin_amdgcn_rcpf(li_l[crow(r, hi)]);
  bf16_t* Ow = Ob + (long)(wid * QBLK) * LDO;
#pragma unroll
  for (int r = 0; r < 16; ++r) { int orow = crow(r, hi);
#pragma unroll
    for (int d0 = 0; d0 < 4; ++d0) Ow[(long)orow * LDO + d0 * 32 + r32] = (bf16_t)f2bf(o[d0][r] * rli[r]); }
#undef SLOAD
#undef SWRITE
#undef SWAIT
#undef RESC
}
}

struct Args { const float* in[22]; float* out; unsigned char* ws; };
enum { I_XP = 0, I_XS, I_CP, I_CS, I_WADA, I_BADA, I_GMPRE, I_GMPOST, I_WIN, I_GQ, I_WQB, I_GKV, I_WKVB, I_WAO, I_WFOUR, I_WOUT, I_GFPRE, I_GFPOST, I_WUP, I_WCONV, I_BCONV, I_WDOWN };

__device__ __forceinline__ int colmap(int kind, int n) {
    if (kind == 0) return n;
    if (kind == 1) {
        if (n < 768) return n;
        if (n < 832) { const int j = n - 768; return OFF_KR + (j >> 1) + ((j & 1) << 5); }
        if (n < 1024) return -1;
        return OFF_G + (n - 1024);
    }
    const int hh = n / 192, j = n % 192;
    if (j < 128) return n;
    const int jj = j - 128; return hh * 192 + 128 + (jj >> 1) + ((jj & 1) << 5);
}
__device__ __forceinline__ void transpose_item(const float* W, int ld, int K, int Nn, bf16_t* WT, int kind, const float* g, LAS float* scr, int item, int lane) {
    const int nblk = Nn / 32, kb = item / nblk, nb = item % nblk, k0 = 64 * kb, n0 = 32 * nb;
    const int sc = colmap(kind, n0 + (lane & 31));
#pragma unroll 8
    for (int i = 0; i < 32; ++i) { const int kk = 2 * i + (lane >> 5); float v = sc >= 0 ? W[(size_t)(k0 + kk) * ld + sc] : 0.f; if (g) v *= g[k0 + kk]; scr[kk * 33 + (lane & 31)] = v; }
    asm volatile("s_waitcnt lgkmcnt(0)" ::: "memory");
    const int c = lane & 7;
#pragma unroll
    for (int j = 0; j < 4; ++j) { const int n = (lane >> 3) + 8 * j; const LAS float* s = scr + (8 * c) * 33 + n;
        u32x4 o; o.x = pk2(s[0 * 33], s[1 * 33]); o.y = pk2(s[2 * 33], s[3 * 33]); o.z = pk2(s[4 * 33], s[5 * 33]); o.w = pk2(s[6 * 33], s[7 * 33]);
        *(u32x4*)(WT + (size_t)(n0 + n) * K + k0 + 8 * c) = o; }
    asm volatile("s_waitcnt lgkmcnt(0)" ::: "memory");
}

__device__ __forceinline__ void row_phase(const float* xin, float* xout, const bf16_t* y, const float* gpost, int gt_off, const float* gpre, int sc_off, int sh_off,
                                          bf16_t* hout, const float* modg, const float* modh, int bg0, int lgS, float* z0, float* z1, int gw, int NGW, int lane) {
    for (int t = gw; t < T; t += NGW) {
        const float* mrow = modh + (size_t)(bg0 + (t >> lgS)) * 6144;
        const float* grow = modg + (size_t)(bg0 + (t >> lgS)) * 6144;
        const f32x4* xr = (const f32x4*)(xin + (size_t)t * DM) + lane;
        f32x4 v[4];
#pragma unroll
        for (int j = 0; j < 4; ++j) v[j] = xr[64 * j];
        if (y) {
            const u32x2* yr = (const u32x2*)(y + (size_t)t * DM) + lane;
            f32x4 yv[4]; float s = 0.f;
#pragma unroll
            for (int j = 0; j < 4; ++j) { const u32x2 w = yr[64 * j]; yv[j] = (f32x4){bf_lo(w.x), bf_hi(w.x), bf_lo(w.y), bf_hi(w.y)};
                s += (yv[j][0] * yv[j][0] + yv[j][1] * yv[j][1]) + (yv[j][2] * yv[j][2] + yv[j][3] * yv[j][3]); }
            const float rs = __builtin_amdgcn_rsqf(wave_sum(s) * (1.f / DM) + EPS);
            f32x4* xo = (f32x4*)(xout + (size_t)t * DM) + lane;
#pragma unroll
            for (int j = 0; j < 4; ++j) { const f32x4 gp = *((const f32x4*)gpost + lane + 64 * j), gt = *((const f32x4*)(grow + gt_off) + lane + 64 * j);
                v[j] = v[j] + gt * (yv[j] * rs * gp); xo[64 * j] = v[j]; }
        }
        if (hout) {
            float s = 0.f;
#pragma unroll
            for (int j = 0; j < 4; ++j) s += (v[j][0] * v[j][0] + v[j][1] * v[j][1]) + (v[j][2] * v[j][2] + v[j][3] * v[j][3]);
            const float rs = __builtin_amdgcn_rsqf(wave_sum(s) * (1.f / DM) + EPS);
            u32x2* ho = (u32x2*)(hout + (size_t)t * DM) + lane;
#pragma unroll
            for (int j = 0; j < 4; ++j) { const f32x4 gp = *((const f32x4*)gpre + lane + 64 * j), sc = *((const f32x4*)(mrow + sc_off) + lane + 64 * j), sh = *((const f32x4*)(mrow + sh_off) + lane + 64 * j);
                const f32x4 h = (v[j] * rs * gp) * (sc + 1.f) + sh; u32x2 w; w.x = pk2(h[0], h[1]); w.y = pk2(h[2], h[3]); ho[64 * j] = w; }
        }
        if (z0 && lane == 0) { z0[t] = 0.f; z1[t] = 0.f; }
    }
}

__device__ __forceinline__ float gelu_tanh(float a) {
    const float z = 1.5957691216057308f * (a + 0.044715f * a * a * a);
    return __fdividef(a, 1.f + __expf(-z));
}
__device__ __forceinline__ void conv_phase(const bf16_t* UP, bf16_t* ACT, const float* wconv, const float* bconv, int S, int gtid, int nthreads) {
    constexpr int NJB = DFF / 8;
    for (int idx = gtid; idx < (T / 8) * NJB; idx += nthreads) {
        const int jb = idx % NJB, tb = idx / NJB, j0 = jb * 8, t0 = tb * 8, pos0 = t0 & (S - 1);
        float wa[3][8], wb[3][8], ba[8], bb[8];
#pragma unroll
        for (int q = 0; q < 3; ++q)
#pragma unroll
            for (int e = 0; e < 8; e += 4) { const f32x4 a = *(const f32x4*)(wconv + q * NUP + j0 + e), b = *(const f32x4*)(wconv + q * NUP + DFF + j0 + e);
                wa[q][e] = a[0]; wa[q][e + 1] = a[1]; wa[q][e + 2] = a[2]; wa[q][e + 3] = a[3]; wb[q][e] = b[0]; wb[q][e + 1] = b[1]; wb[q][e + 2] = b[2]; wb[q][e + 3] = b[3]; }
#pragma unroll
        for (int e = 0; e < 8; e += 4) { const f32x4 a = *(const f32x4*)(bconv + j0 + e), b = *(const f32x4*)(bconv + DFF + j0 + e);
            ba[e] = a[0]; ba[e + 1] = a[1]; ba[e + 2] = a[2]; ba[e + 3] = a[3]; bb[e] = b[0]; bb[e + 1] = b[1]; bb[e + 2] = b[2]; bb[e + 3] = b[3]; }
        const u32x4 zero4 = {0u, 0u, 0u, 0u};
        const bf16_t* base = UP + (size_t)t0 * NUP + j0;
        u32x4 pa = zero4, pb = zero4, ca, cb, na, nb;
        if (pos0 > 0) { pa = *(const u32x4*)(base - NUP); pb = *(const u32x4*)(base - NUP + DFF); }
        ca = *(const u32x4*)base; cb = *(const u32x4*)(base + DFF);
#pragma unroll
        for (int i = 0; i < 8; ++i) {
            if (pos0 + i + 1 < S) { na = *(const u32x4*)(base + (size_t)(i + 1) * NUP); nb = *(const u32x4*)(base + (size_t)(i + 1) * NUP + DFF); } else { na = zero4; nb = zero4; }
            float r[8];
#pragma unroll
            for (int e = 0; e < 8; ++e) {
                const unsigned wpa = pa[e >> 1], wca = ca[e >> 1], wna = na[e >> 1], wpb = pb[e >> 1], wcb = cb[e >> 1], wnb = nb[e >> 1];
                const float xa0 = (e & 1) ? bf_hi(wpa) : bf_lo(wpa), xa1 = (e & 1) ? bf_hi(wca) : bf_lo(wca), xa2 = (e & 1) ? bf_hi(wna) : bf_lo(wna);
                const float xb0 = (e & 1) ? bf_hi(wpb) : bf_lo(wpb), xb1 = (e & 1) ? bf_hi(wcb) : bf_lo(wcb), xb2 = (e & 1) ? bf_hi(wnb) : bf_lo(wnb);
                const float va = xa0 * wa[0][e] + xa1 * wa[1][e] + xa2 * wa[2][e] + ba[e];
                const float vb = xb0 * wb[0][e] + xb1 * wb[1][e] + xb2 * wb[2][e] + bb[e];
                r[e] = gelu_tanh(va) * vb;
            }
            u32x4 o; o.x = pk2(r[0], r[1]); o.y = pk2(r[2], r[3]); o.z = pk2(r[4], r[5]); o.w = pk2(r[6], r[7]);
            *(u32x4*)(ACT + (size_t)(t0 + i) * DFF + j0) = o;
            pa = ca; pb = cb; ca = na; cb = nb;
        }
    }
}

__global__ void __launch_bounds__(512, 2) fwd_megakernel(Args args) {
#define PH_ENTER() \
    unsigned char* ws = args.ws; asm volatile("" : "+s"(ws)); \
    int bx = blockIdx.x; asm volatile("" : "+s"(bx)); int G = gridDim.x; asm volatile("" : "+s"(G)); \
    int tid = threadIdx.x; asm volatile("" : "+v"(tid)); \
    const int lane = tid & 63, wave = __builtin_amdgcn_readfirstlane(tid >> 6); \
    const int gw = bx * 8 + wave, NGW = G * 8, gtid = bx * 512 + tid, NT_ALL = G * 512; \
    (void)lane; (void)wave; (void)gw; (void)NGW; (void)gtid; (void)NT_ALL;
#define WSP(T_, off) ((T_*)(ws + (off)))
    extern __shared__ __attribute__((aligned(16))) unsigned char lds_raw[];
    cg::grid_group grid = cg::this_grid();
    LAS unsigned char* lds = (LAS unsigned char*)lds_raw;
    {
    PH_ENTER();
    float* rope = WSP(float, WS_ROPE); float* mod = WSP(float, WS_MOD); bf16_t* Wb = WSP(bf16_t, WS_W); bf16_t* D2 = WSP(bf16_t, WS_D2); bf16_t* D4 = WSP(bf16_t, WS_D4);
    {
        for (int it = bx; it < DEPTH * 16 * 4; it += G) {
            const int l = it >> 6, kb = (it >> 2) & 15, g = it & 3, k0 = kb * 64;
            LAS float* tile = (LAS float*)lds;
            LAS float* cs = (LAS float*)(lds + 64 * 129 * 4);
            const float* Wsrc = args.in[I_WIN] + (size_t)l * DM * INW;
            for (int e = tid; e < 64 * 128; e += 512) { const int kk = e >> 7, c = e & 127; tile[kk * 129 + c] = Wsrc[(size_t)(k0 + kk) * INW + OFF_F + g * 128 + c]; }
            if (tid < 128) { const float rev = (float)tid * (1.f / 128.f); cs[2 * tid] = __builtin_amdgcn_cosf(rev); cs[2 * tid + 1] = __builtin_amdgcn_sinf(rev); }
            __syncthreads();
            const int k = lane, cp0 = wave * 16;
            float aC[16], aS[16];
#pragma unroll
            for (int j = 0; j < 16; ++j) { aC[j] = 0.f; aS[j] = 0.f; }
            for (int c = 0; c < 128; ++c) { const float x = tile[k * 129 + c];
#pragma unroll
                for (int j = 0; j < 16; ++j) { const int idx = (c * (cp0 + j)) & 127; aC[j] += x * cs[2 * idx]; aS[j] += x * cs[2 * idx + 1]; } }
            bf16_t* WF = Wb + (size_t)l * W_LAYER + W_F;
#pragma unroll
            for (int j = 0; j < 16; ++j) { WF[(size_t)(g * 128 + cp0 + j) * DM + k0 + k] = (bf16_t)f2bf(aC[j]); WF[(size_t)(512 + g * 128 + cp0 + j) * DM + k0 + k] = (bf16_t)f2bf(aS[j]); }
            __syncthreads();
        }
        for (int it = bx; it < DEPTH * 12; it += G) {
            const int l = it / 12, col = (it % 12) * 512 + tid;
            LAS float* sl = (LAS float*)lds;
            float acc[NB_ALL];
#pragma unroll
            for (int b = 0; b < NB_ALL; ++b) acc[b] = 0.f;
            const float* Wa = args.in[I_WADA] + (size_t)l * DM * 6144;
            for (int kc = 0; kc < 16; ++kc) {
                __syncthreads();
                for (int e = tid; e < 64 * NB_ALL; e += 512) { const int kk = e & 63, b = e >> 6;
                    const float v = b < 32 ? args.in[I_CP][b * DM + kc * 64 + kk] : args.in[I_CS][(b - 32) * DM + kc * 64 + kk];
                    sl[kk * NB_ALL + b] = v * sigmoidf_(v); }
                __syncthreads();
                for (int kk = 0; kk < 64; ++kk) { const float wv = Wa[(size_t)(kc * 64 + kk) * 6144 + col];
#pragma unroll
                    for (int b = 0; b < NB_ALL; b += 4) { const f32x4 s4 = *(const LAS f32x4*)(sl + kk * NB_ALL + b); acc[b] += s4[0] * wv; acc[b + 1] += s4[1] * wv; acc[b + 2] += s4[2] * wv; acc[b + 3] += s4[3] * wv; } }
            }
            const float bias = args.in[I_BADA][l * 6144 + col];
#pragma unroll
            for (int b = 0; b < NB_ALL; ++b) mod[(size_t)(l * NB_ALL + b) * 6144 + col] = acc[b] + bias;
            __syncthreads();
        }
        {
            LAS float* scr = (LAS float*)(lds + wave * 16384);
            constexpr int NI0 = 1536, NI1 = 384, NI2 = 256, NI3 = 512, NI4 = 256, NI5 = 512, NI6 = 2816, NI7 = 1408, NIL = NI0 + NI1 + NI2 + NI3 + NI4 + NI5 + NI6 + NI7;
            for (int it = gw; it < DEPTH * NIL; it += NGW) {
                const int l = it / NIL; int r = it % NIL; bf16_t* WL = Wb + (size_t)l * W_LAYER;
                if (r < NI0) { transpose_item(args.in[I_WIN] + (size_t)l * DM * INW, INW, 1024, NZ1, WL + W_IN, 1, nullptr, scr, r, lane); continue; } r -= NI0;
                if (r < NI1) { transpose_item(args.in[I_WQB] + (size_t)l * 512 * NQ, NQ, 512, NQ, WL + W_QB, 2, args.in[I_GQ] + l * 512, scr, r, lane); continue; } r -= NI1;
                if (r < NI2) { transpose_item(args.in[I_WKVB] + (size_t)l * 256 * NKV, NKV, 256, NKV, WL + W_KVB, 0, args.in[I_GKV] + l * 256, scr, r, lane); continue; } r -= NI2;
                if (r < NI3) { transpose_item(args.in[I_WAO] + (size_t)l * DM * DM, DM, 1024, DM, WL + W_AO, 0, nullptr, scr, r, lane); continue; } r -= NI3;
                if (r < NI4) { transpose_item(args.in[I_WFOUR] + (size_t)l * 512 * DM, DM, 512, DM, WL + W_FOUR, 0, nullptr, scr, r, lane); continue; } r -= NI4;
                if (r < NI5) { transpose_item(args.in[I_WOUT] + (size_t)l * DM * DM, DM, 1024, DM, WL + W_OUT, 0, nullptr, scr, r, lane); continue; } r -= NI5;
                if (r < NI6) { transpose_item(args.in[I_WUP] + (size_t)l * DM * NUP, NUP, 1024, NUP, WL + W_UP, 0, nullptr, scr, r, lane); continue; } r -= NI6;
                transpose_item(args.in[I_WDOWN] + (size_t)l * DFF * DM, DM, DFF, DM, WL + W_DOWN, 0, nullptr, scr, r, lane);
            }
        }
        for (int sel = 0; sel < 2; ++sel) {
            const int S = sel ? 4096 : 2048, lg = sel ? 12 : 11; bf16_t* Dm = sel ? D4 : D2;
            const int per_row = 2 * S / 8, nitems = S * per_row; const float inv = 1.f / (float)S;
            for (int it = gtid; it < nitems; it += NT_ALL) {
                const int sp = it / per_row, k8 = (it % per_row) * 8; const bool isSin = k8 >= S; const int kbase = k8 & (S - 1);
                float v[8];
#pragma unroll
                for (int e = 0; e < 8; ++e) { const float rev = (float)((sp * (kbase + e)) & (S - 1)) * inv; v[e] = isSin ? -__builtin_amdgcn_sinf(rev) : __builtin_amdgcn_cosf(rev); }
                u32x4 o; o.x = pk2(v[0], v[1]); o.y = pk2(v[2], v[3]); o.z = pk2(v[4], v[5]); o.w = pk2(v[6], v[7]);
                *(u32x4*)(Dm + ((size_t)sp << (lg + 1)) + k8) = o;
            }
        }
        for (int it = gtid; it < 4096 * 32; it += NT_ALL) {
            const int pos = it >> 5, i = it & 31;
            const float invf = __builtin_amdgcn_exp2f(-(float)i * (13.287712379549449f / 32.f));
            const float ang = (float)pos * invf;
            const float n = rintf(ang * 0.15915494309189535f);
            float r = fmaf(-n, 6.2831855f, ang); r = fmaf(n, 1.7484556e-7f, r);
            const float rev = r * 0.15915494309189535f;
            rope[2 * it] = __builtin_amdgcn_cosf(rev); rope[2 * it + 1] = __builtin_amdgcn_sinf(rev);
        }
    }
    }
    grid.sync();

    for (int c = 0; c < NCHUNK; ++c) {
        {
            PH_ENTER();
            const int lgS = c < 4 ? 11 : 12, bg0 = c < 4 ? 8 * c : 32;
            const float* xin = c < 4 ? args.in[I_XP] + (size_t)c * T * DM : args.in[I_XS];
            row_phase(xin, nullptr, nullptr, nullptr, 0, args.in[I_GMPRE], 1024, 0, WSP(bf16_t, WS_H), WSP(float, WS_MOD), WSP(float, WS_MOD), bg0, lgS, nullptr, nullptr, gw, NGW, lane);
        }
        grid.sync();
        for (int l = 0; l < DEPTH; ++l) {
            {
                PH_ENTER();
                const int S = c < 4 ? 2048 : 4096, lgS = c < 4 ? 11 : 12;
                const bf16_t* WL = WSP(bf16_t, WS_W) + (size_t)l * W_LAYER; bf16_t* Hb = WSP(bf16_t, WS_H);
                pg8::Gemm g{Hb, WL + W_IN, 1024, 1024, 1024, 0, 0}; pg8::StaticOrder so; so.init(T, NZ1, G, bx);
                pg8::EpiIn E{WSP(bf16_t, WS_Z1), WSP(bf16_t, WS_KR), WSP(float, WS_RQ), WSP(float, WS_ROPE), S};
                pg8::gemm_phase<pg8::EpiIn, pg8::StaticOrder, true>(lds, g, so, E);
            }
            {
                PH_ENTER();
                const int S = c < 4 ? 2048 : 4096, lgS = c < 4 ? 11 : 12;
                const bf16_t* WL = WSP(bf16_t, WS_W) + (size_t)l * W_LAYER; bf16_t* Hb = WSP(bf16_t, WS_H);
                pg8::Gemm g2{WL + W_F, Hb, 1024, 1024, 1024, 0, 0}; pg8::StaticOrder so2; so2.init(1024, T, G, bx);
                pg8::EpiUT E2{WSP(bf16_t, WS_UT), S, lgS};
                pg8::gemm_phase<pg8::EpiUT, pg8::StaticOrder, true>(lds, g2, so2, E2);
            }
            grid.sync();
            {
                PH_ENTER();
                const int S = c < 4 ? 2048 : 4096;
                const bf16_t* WL = WSP(bf16_t, WS_W) + (size_t)l * W_LAYER;
                pg8::Gemm g{WSP(bf16_t, WS_Z1), WL + W_QB, 512, NZ1, 512, 0, 0}; pg8::StaticOrder so; so.init(T, NQ, G, bx);
                pg8::EpiQ E{WSP(bf16_t, WS_Q), WSP(float, WS_RQ), WSP(float, WS_ROPE), S};
                pg8::gemm_phase<pg8::EpiQ, pg8::StaticOrder, true>(lds, g, so, E);
            }
            {
                PH_ENTER();
                const bf16_t* WL = WSP(bf16_t, WS_W) + (size_t)l * W_LAYER;
                pg8::Gemm g2{WSP(bf16_t, WS_Z1) + 512, WL + W_KVB, 256, NZ1, 256, 0, 0}; pg8::StaticOrder so2; so2.init(T, NKV, G, bx);
                pg8::EpiKV E2{WSP(bf16_t, WS_KV), WSP(float, WS_RQ)};
                pg8::gemm_phase<pg8::EpiKV, pg8::StaticOrder, true>(lds, g2, so2, E2);
            }
            grid.sync();
            {
                PH_ENTER();
                const int S = c < 4 ? 2048 : 4096, nseq = T / S, nqb = S / 256;
                int d_first, d_step;
                if (G == 256) { d_first = bx < 128 ? -1 : bx - 128; d_step = 128; } else { d_first = bx; d_step = G; }
                if (d_first >= 0) {
                    const bf16_t* Dm = c < 4 ? WSP(bf16_t, WS_D2) : WSP(bf16_t, WS_D4);
                    pg8::Gemm g{Dm, WSP(bf16_t, WS_UT), 2 * S, 2 * S, 2 * S, 0, (size_t)512 * 2 * S}; pg8::DftOrder so{d_first, d_step, nseq * nqb * 2, nqb};
                    pg8::EpiDft E{WSP(bf16_t, WS_FO), S, __builtin_amdgcn_rsqf((float)S * 128.f)};
                    pg8::gemm_phase<pg8::EpiDft, pg8::DftOrder, true>(lds, g, so, E);
                }
            }
            {
                PH_ENTER();
                const int S = c < 4 ? 2048 : 4096, nseq = T / S, nqb = S / 256;
                const int nau = nseq * 8 * nqb;
                int a_first, a_cnt, a_step;
                if (G == 256) { if (bx < 128) { a_first = 3 * bx; a_cnt = 3; } else { a_first = 384 + (bx - 128); a_cnt = 1; } a_step = 1; }
                else { a_first = bx; a_step = G; a_cnt = (nau - bx + G - 1) / G; }
                const bf16_t* Qb = WSP(bf16_t, WS_Q); const bf16_t* KVb = WSP(bf16_t, WS_KV); const bf16_t* KRb = WSP(bf16_t, WS_KR); bf16_t* AO = WSP(bf16_t, WS_AO);
                for (int i = 0; i < a_cnt; ++i) {
                    const int u = a_first + i * a_step; if (u >= nau) break;
                    const int qb = u % nqb, h = (u / nqb) & 7, b = u / (nqb * 8);
                    const size_t r0 = (size_t)b * S;
                    __syncthreads();
                    att::attn_unit(Qb + (r0 + (size_t)qb * 256) * NQ + h * 192, KVb + r0 * NKV + h * 256, KVb + r0 * NKV + h * 256 + 128, KRb + r0 * 64,
                                   AO + (r0 + (size_t)qb * 256) * DM + h * 128, S, (char*)lds_raw);
                }
            }
            grid.sync();
            {
                PH_ENTER();
                const bf16_t* WL = WSP(bf16_t, WS_W) + (size_t)l * W_LAYER;
                pg8::Gemm g{WSP(bf16_t, WS_AO), WL + W_AO, 1024, 1024, 1024, 0, 0}; pg8::StaticOrder so; so.init(T, DM, G, bx);
                pg8::EpiMerge<false> E{WSP(bf16_t, WS_MG), WSP(bf16_t, WS_Z1), 1024};
                pg8::gemm_phase<pg8::EpiMerge<false>, pg8::StaticOrder, true>(lds, g, so, E);
            }
            {
                PH_ENTER();
                const bf16_t* WL = WSP(bf16_t, WS_W) + (size_t)l * W_LAYER;
                pg8::Gemm g2{WSP(bf16_t, WS_FO), WL + W_FOUR, 512, 512, 512, 0, 0}; pg8::StaticOrder so; so.init(T, DM, G, bx);
                pg8::EpiMerge<true> E2{WSP(bf16_t, WS_MG), WSP(bf16_t, WS_Z1), 2048};
                pg8::gemm_phase<pg8::EpiMerge<true>, pg8::StaticOrder, true>(lds, g2, so, E2);
            }
            grid.sync();
            {
                PH_ENTER();
                const bf16_t* WL = WSP(bf16_t, WS_W) + (size_t)l * W_LAYER;
                pg8::Gemm g{WSP(bf16_t, WS_MG), WL + W_OUT, 1024, 1024, 1024, 0, 0}; pg8::StaticOrder so; so.init(T, DM, G, bx);
                pg8::EpiStore E{WSP(bf16_t, WS_Y), DM};
                pg8::gemm_phase<pg8::EpiStore, pg8::StaticOrder, true>(lds, g, so, E);
            }
            grid.sync();
            {
                PH_ENTER();
                const int lgS = c < 4 ? 11 : 12, bg0 = c < 4 ? 8 * c : 32;
                const float* xin = c < 4 ? args.in[I_XP] + (size_t)c * T * DM : args.in[I_XS];
                float* xres = args.out + (size_t)c * T * DM;
                const float* modl = WSP(float, WS_MOD) + (size_t)l * NB_ALL * 6144;
                row_phase(l == 0 ? xin : xres, xres, WSP(bf16_t, WS_Y), args.in[I_GMPOST] + l * DM, 2048, args.in[I_GFPRE] + l * DM, 4096, 3072, WSP(bf16_t, WS_H), modl, modl, bg0, lgS, nullptr, nullptr, gw, NGW, lane);
            }
            grid.sync();
            {
                PH_ENTER();
                const bf16_t* WL = WSP(bf16_t, WS_W) + (size_t)l * W_LAYER;
                pg8::Gemm g{WSP(bf16_t, WS_H), WL + W_UP, 1024, 1024, 1024, 0, 0}; pg8::StaticOrder so; so.init(T, NUP, G, bx);
                pg8::EpiStore E{WSP(bf16_t, WS_UP), NUP};
                pg8::gemm_phase<pg8::EpiStore, pg8::StaticOrder, true>(lds, g, so, E);
            }
            grid.sync();
            {
                PH_ENTER();
                const int S = c < 4 ? 2048 : 4096;
                conv_phase(WSP(bf16_t, WS_UP), WSP(bf16_t, WS_ACT), args.in[I_WCONV] + (size_t)l * 3 * NUP, args.in[I_BCONV] + (size_t)l * NUP, S, gtid, NT_ALL);
            }
            grid.sync();
            {
                PH_ENTER();
                const bf16_t* WL = WSP(bf16_t, WS_W) + (size_t)l * W_LAYER;
                pg8::Gemm g{WSP(bf16_t, WS_ACT), WL + W_DOWN, DFF, DFF, DFF, 0, 0}; pg8::StaticOrder so; so.init(T, DM, G, bx);
                pg8::EpiStore E{WSP(bf16_t, WS_Y), DM};
                pg8::gemm_phase<pg8::EpiStore, pg8::StaticOrder, true>(lds, g, so, E);
            }
            grid.sync();
            {
                PH_ENTER();
                const int lgS = c < 4 ? 11 : 12, bg0 = c < 4 ? 8 * c : 32;
                float* xres = args.out + (size_t)c * T * DM;
                const float* modl = WSP(float, WS_MOD) + (size_t)l * NB_ALL * 6144;
                if (l + 1 < DEPTH)
                    row_phase(xres, xres, WSP(bf16_t, WS_Y), args.in[I_GFPOST] + l * DM, 5120, args.in[I_GMPRE] + (l + 1) * DM, 1024, 0, WSP(bf16_t, WS_H), modl, modl + (size_t)NB_ALL * 6144, bg0, lgS, nullptr, nullptr, gw, NGW, lane);
                else
                    row_phase(xres, xres, WSP(bf16_t, WS_Y), args.in[I_GFPOST] + l * DM, 5120, nullptr, 0, 0, nullptr, modl, modl, bg0, lgS, nullptr, nullptr, gw, NGW, lane);
            }
            grid.sync();
        }
    }
}

extern "C" void kernel_launch(void* const* d_in, const int* in_sizes, int n_in, void* d_out, int out_size, void* d_ws, size_t ws_size, hipStream_t stream) {
    static int grid = 0;
    if (grid == 0) {
        if (n_in != 22 || ws_size < WS_END || out_size != 81920 * DM) { fprintf(stderr, "kernel_launch: unexpected shapes (n_in %d, out %d, ws %zu)\n", n_in, out_size, ws_size); grid = -1; return; }
        int dev = 0, cus = 0, per_cu = 0;
        hipGetDevice(&dev); hipDeviceGetAttribute(&cus, hipDeviceAttributeMultiprocessorCount, dev);
        if (hipFuncSetAttribute((const void*)fwd_megakernel, hipFuncAttributeMaxDynamicSharedMemorySize, LDS_BYTES) != hipSuccess) { fprintf(stderr, "hipFuncSetAttribute failed\n"); grid = -1; return; }
        hipOccupancyMaxActiveBlocksPerMultiprocessor(&per_cu, (const void*)fwd_megakernel, 512, LDS_BYTES);
        (void)hipGetLastError();
        if (per_cu < 1) { fprintf(stderr, "occupancy query says %d blocks per CU\n", per_cu); per_cu = 1; }
        grid = cus;
    }
    if (grid < 0) return;
    Args a{};
    for (int i = 0; i < 22; ++i) a.in[i] = (const float*)d_in[i];
    a.out = (float*)d_out; a.ws = (unsigned char*)d_ws;
    void* kargs[] = {&a};
    hipError_t e = hipLaunchCooperativeKernel((void*)fwd_megakernel, dim3(grid), dim3(512), kargs, LDS_BYTES, stream);
    if (e != hipSuccess) fprintf(stderr, "cooperative launch failed: %s (grid %d)\n", hipGetErrorString(e), grid);
}
```

```cpp
#include <hip/hip_runtime.h>
#include <hip/hip_cooperative_groups.h>
#include <cstdio>
#include <cstdint>
namespace cg = cooperative_groups;

#define LAS __attribute__((address_space(3)))
typedef unsigned short bf16_t;
typedef short bf16x8 __attribute__((ext_vector_type(8)));
typedef short s16x4 __attribute__((ext_vector_type(4)));
typedef float f32x4 __attribute__((ext_vector_type(4)));
typedef float f32x2 __attribute__((ext_vector_type(2)));
typedef float f32x16 __attribute__((ext_vector_type(16)));
typedef unsigned u32x4 __attribute__((ext_vector_type(4)));
typedef unsigned u32x2 __attribute__((ext_vector_type(2)));

constexpr int DM = 1024, DEPTH = 4, NB_ALL = 36;
constexpr int INW = 3392, OFF_KR = 768, OFF_F = 832, OFF_G = 1344;
constexpr int NZ1 = 3072, NQ = 1536, NKV = 2048, DFF = 2816, NUP = 5632;
constexpr int T = 16384, NCHUNK = 5;
constexpr float EPS = 1e-6f;

constexpr size_t MiB = 1u << 20;
constexpr size_t WS_ROPE = 1 * MiB;
constexpr size_t WS_MOD = 2 * MiB;
constexpr size_t WS_RQ = 6 * MiB;
constexpr size_t WS_RKV = 6 * MiB + 256 * 1024;
constexpr size_t WS_W = 8 * MiB;
constexpr size_t WS_D2 = 136 * MiB;
constexpr size_t WS_D4 = 152 * MiB;
constexpr size_t WS_H = 216 * MiB;
constexpr size_t WS_Z1 = 248 * MiB;
constexpr size_t WS_UT = 344 * MiB;
constexpr size_t WS_Q = 376 * MiB;
constexpr size_t WS_UP = 248 * MiB;
constexpr size_t WS_KV = 424 * MiB;
constexpr size_t WS_KR = 488 * MiB;
constexpr size_t WS_AO = 490 * MiB;
constexpr size_t WS_FO = 522 * MiB;
constexpr size_t WS_MG = 538 * MiB;
constexpr size_t WS_Y = 570 * MiB;
constexpr size_t WS_ACT = 602 * MiB;
constexpr size_t WS_END = 690 * MiB;
constexpr size_t W_IN = 0, W_F = 3145728, W_QB = 4194304, W_KVB = 4980736, W_AO = 5505024, W_FOUR = 6553600, W_OUT = 7077888, W_UP = 8126464, W_DOWN = 13893632, W_LAYER = 16777216;

constexpr int LDS_BYTES = 135168;

__device__ __forceinline__ unsigned f2bf(float f) { unsigned u = __builtin_bit_cast(unsigned, f); return (u + 0x7fffu + ((u >> 16) & 1u)) >> 16; }
__device__ __forceinline__ unsigned pk2(float lo, float hi) { return f2bf(lo) | (f2bf(hi) << 16); }
__device__ __forceinline__ float bf_lo(unsigned w) { return __builtin_bit_cast(float, w << 16); }
__device__ __forceinline__ float bf_hi(unsigned w) { return __builtin_bit_cast(float, w & 0xffff0000u); }
__device__ __forceinline__ unsigned cvt_pk_bf16(float lo, float hi) { unsigned r; asm volatile("v_cvt_pk_bf16_f32 %0, %1, %2" : "=v"(r) : "v"(lo), "v"(hi)); return r; }
__device__ __forceinline__ float wave_sum(float v) {
#pragma unroll
    for (int o = 1; o < 64; o <<= 1) v += __shfl_xor(v, o);
    return v;
}
__device__ __forceinline__ float sigmoidf_(float x) { return __fdividef(1.f, 1.f + __expf(-x)); }

namespace pg8 {
constexpr int BM = 256, BK = 64, HALF = 128, HTB = HALF * BK * 2, STAGE_BYTES = 8 * HTB, NXCD = 8, WGM = 8;
__host__ __device__ __forceinline__ int lds_byte(int r, int c) { const int st = (r >> 4) * 2 + (c >> 5), rr = r & 15, cc = c & 31, ob = rr * 64 + cc * 2; return st * 1024 + (ob ^ (((ob >> 9) & 1) << 5)); }
__host__ __device__ __forceinline__ void stage_rc(int b, int& R, int& C) { const int st = b / 1024, sb = b % 1024, swz = sb ^ (((sb >> 9) & 1) << 5); R = (st >> 1) * 16 + swz / 64; C = (st & 1) * 32 + (swz % 64) / 2; }
__host__ __device__ __forceinline__ int perm32(int rho) { const int n = rho >> 4, i = rho & 15; return 8 * (i >> 2) + 4 * n + (i & 3); }

struct Unit { int pm, pn, bz; };
struct Gemm { const bf16_t* A; const bf16_t* Bt; int K, lda, ldb; size_t bsA, bsB; };

struct StaticOrder {
    int nM, nN, nwg, G, c;
    __device__ void init(int M, int N, int G_, int c_) { nM = M / BM; nN = N / BM; nwg = nM * nN; G = G_; c = c_; }
    __device__ bool next(int i, Unit& u) const {
        const long L = (long)i * G + c; if (L >= nwg) return false;
        int wgid = (int)L; { const int q = nwg / NXCD, r = nwg % NXCD, xcd = wgid % NXCD, off = wgid / NXCD; wgid = (xcd < r ? xcd * (q + 1) : r * (q + 1) + (xcd - r) * q) + off; }
        const int nig = WGM * nN, gid = wgid / nig, fm = gid * WGM, gsz = (nM - fm) < WGM ? (nM - fm) : WGM;
        u.pm = fm + ((wgid % nig) % gsz); u.pn = (wgid % nig) / gsz; u.bz = 0; return true;
    }
};
struct DftOrder {
    int first, step, count, nqb;
    __device__ bool next(int i, Unit& u) const {
        if (first < 0) return false; const int L = first + i * step; if (L >= count) return false;
        u.pn = L & 1; u.pm = (L >> 1) % nqb; u.bz = (L >> 1) / nqb; return true;
    }
};

template <class Epi, class Sched, bool ALIGN_EPI>
__device__ __forceinline__ void gemm_phase(LAS unsigned char* lds, const Gemm g, const Sched& S, const Epi& E) {
    int tid_ = threadIdx.x; asm volatile("" : "+v"(tid_));
    const int tid = tid_, wid = __builtin_amdgcn_readfirstlane(tid >> 6), lane = tid & 63, wr = wid >> 2, wc = wid & 3, fr = lane & 15, fq = lane >> 4;
    const int K = g.K, nt = K / BK;
    unsigned voffA[2], voffB[2];
#pragma unroll
    for (int i = 0; i < 2; ++i) { int R, C; stage_rc(tid * 16 + i * 8192, R, C); const int Rb = (R & ~31) + perm32(R & 31);
        voffA[i] = (unsigned)(R * g.lda + C) * 2u; voffB[i] = (unsigned)(Rb * g.ldb + C) * 2u; }
    const size_t kstep = (size_t)(BK * 2);
    const size_t hstepA = (size_t)HALF * g.lda * 2, hstepB = (size_t)HALF * g.ldb * 2;
    const size_t tstepA = 2 * hstepA, tstepB = 2 * hstepB;
    const unsigned ldsw = (unsigned)wid * 1024u;
    const int aoff = lds_byte(wr * 64 + fr, fq * 8), boff = lds_byte(wc * 32 + fr, fq * 8);
#define PG8_SA(b, h) (((b) * 2 + (h)) * HTB)
#define PG8_SB(b, h) ((4 + (b) * 2 + (h)) * HTB)
#define PG8_STAGE(bufoff, gbase, voff) do { _Pragma("unroll") for (int _i = 0; _i < 2; ++_i) \
        __builtin_amdgcn_global_load_lds((const unsigned*)((const char*)(gbase) + (voff)[_i]), (LAS unsigned*)(lds + (bufoff) + ldsw + _i * 8192), 16, 0, 0); } while (0)
#define PG8_LDA(dst, b, h) do { _Pragma("unroll") for (int m = 0; m < 4; ++m) _Pragma("unroll") for (int k = 0; k < 2; ++k) dst[m][k] = *(const LAS bf16x8*)(lds + PG8_SA(b, h) + aoff + m * 2048 + k * 1024); } while (0)
#define PG8_LDB(dst, b, h) do { _Pragma("unroll") for (int n = 0; n < 2; ++n) _Pragma("unroll") for (int k = 0; k < 2; ++k) dst[n][k] = *(const LAS bf16x8*)(lds + PG8_SB(b, h) + boff + n * 2048 + k * 1024); } while (0)
#define PG8_MMA(ai, bj, At, Bt) do { __builtin_amdgcn_s_setprio(1); _Pragma("unroll") for (int m = 0; m < 4; ++m) _Pragma("unroll") for (int n = 0; n < 2; ++n) _Pragma("unroll") for (int k = 0; k < 2; ++k) \
        acc[ai][bj][m][n] = __builtin_amdgcn_mfma_f32_16x16x32_bf16(Bt[n][k], At[m][k], acc[ai][bj][m][n], 0, 0, 0); __builtin_amdgcn_s_setprio(0); } while (0)
#define PG8_WAIT_V(n) asm volatile("s_waitcnt vmcnt(" #n ")" ::: "memory")
#define PG8_WAIT_L(n) asm volatile("s_waitcnt lgkmcnt(" #n ")" ::: "memory")
#define PG8_BAR __builtin_amdgcn_s_barrier()
#define PG8_SCHED __builtin_amdgcn_sched_barrier(0)
    Unit cur, nxt; int ui = 0;
    if (!S.next(0, cur)) return;
    f32x4 acc[2][2][4][2];
#pragma unroll
    for (int a = 0; a < 2; ++a)
#pragma unroll
        for (int b = 0; b < 2; ++b)
#pragma unroll
            for (int m = 0; m < 4; ++m)
#pragma unroll
                for (int n = 0; n < 2; ++n) acc[a][b][m][n] = (f32x4){0.f, 0.f, 0.f, 0.f};
    bf16x8 At[4][2], B0[2][2], B1[2][2];
    const char* cA = (const char*)g.A + (size_t)cur.bz * g.bsA * 2 + (size_t)cur.pm * tstepA;
    const char* cB = (const char*)g.Bt + (size_t)cur.bz * g.bsB * 2 + (size_t)cur.pn * tstepB;
    PG8_STAGE(PG8_SB(0, 0), cB, voffB); PG8_STAGE(PG8_SB(0, 1), cB + hstepB, voffB); PG8_STAGE(PG8_SA(0, 0), cA, voffA); PG8_STAGE(PG8_SA(0, 1), cA + hstepA, voffA);
    if (wr == 1) PG8_BAR;
    PG8_WAIT_V(2); PG8_BAR;
    PG8_STAGE(PG8_SB(1, 0), cB + kstep, voffB); PG8_STAGE(PG8_SA(1, 0), cA + kstep, voffA); PG8_STAGE(PG8_SB(1, 1), cB + hstepB + kstep, voffB);
    PG8_WAIT_V(6); PG8_BAR;
    for (;;) {
        const bool has_next = S.next(ui + 1, nxt);
        const char* nA = has_next ? (const char*)g.A + (size_t)nxt.bz * g.bsA * 2 + (size_t)nxt.pm * tstepA : cA;
        const char* nB = has_next ? (const char*)g.Bt + (size_t)nxt.bz * g.bsB * 2 + (size_t)nxt.pn * tstepB : cB;
        for (int t = 0; t < nt; t += 2) {
            const bool last = (t == nt - 2);
            const char* a1 = cA + (size_t)(t + 1) * kstep;
            const char* a2 = last ? nA : cA + (size_t)(t + 2) * kstep; const char* b2 = last ? nB : cB + (size_t)(t + 2) * kstep;
            const char* a3 = a2 + kstep; const char* b3 = b2 + kstep;
            PG8_LDB(B0, 0, 0); PG8_LDB(B1, 0, 1); PG8_SCHED; PG8_LDA(At, 0, 0); PG8_STAGE(PG8_SA(1, 1), a1 + hstepA, voffA);
            PG8_WAIT_V(8); PG8_WAIT_L(0); PG8_BAR; PG8_MMA(0, 0, At, B0); PG8_MMA(0, 1, At, B1); PG8_BAR; PG8_SCHED;
            PG8_LDA(At, 0, 1); PG8_STAGE(PG8_SB(0, 0), b2, voffB); PG8_STAGE(PG8_SB(0, 1), b2 + hstepB, voffB); PG8_STAGE(PG8_SA(0, 0), a2, voffA);
            PG8_WAIT_V(8); PG8_WAIT_L(0); PG8_BAR; PG8_MMA(1, 0, At, B0); PG8_MMA(1, 1, At, B1); PG8_BAR; PG8_SCHED;
            PG8_LDB(B0, 1, 0); PG8_LDB(B1, 1, 1); PG8_SCHED; PG8_LDA(At, 1, 0); PG8_STAGE(PG8_SA(0, 1), a2 + hstepA, voffA);
            PG8_WAIT_V(8); PG8_WAIT_L(0); PG8_BAR; PG8_MMA(0, 0, At, B0); PG8_MMA(0, 1, At, B1); PG8_BAR; PG8_SCHED;
            PG8_LDA(At, 1, 1); PG8_STAGE(PG8_SB(1, 0), b3, voffB); PG8_STAGE(PG8_SB(1, 1), b3 + hstepB, voffB); PG8_STAGE(PG8_SA(1, 0), a3, voffA);
            PG8_WAIT_V(8); PG8_WAIT_L(0); PG8_BAR; PG8_MMA(1, 0, At, B0); PG8_MMA(1, 1, At, B1); PG8_BAR; PG8_SCHED;
        }
        if constexpr (ALIGN_EPI) { if (wr == 0) PG8_BAR; }
        E(acc, cur, wr, wc, fr, fq);
        if (!has_next) break;
#pragma unroll
        for (int a = 0; a < 2; ++a)
#pragma unroll
            for (int b = 0; b < 2; ++b)
#pragma unroll
                for (int m = 0; m < 4; ++m)
#pragma unroll
                    for (int n = 0; n < 2; ++n) acc[a][b][m][n] = (f32x4){0.f, 0.f, 0.f, 0.f};
        cur = nxt; cA = nA; cB = nB; ++ui;
        if constexpr (ALIGN_EPI) { if (wr == 1) PG8_BAR; }
    }
    PG8_WAIT_V(0);
    if constexpr (!ALIGN_EPI) { if (wr == 0) PG8_BAR; }
    PG8_BAR;
#undef PG8_SA
#undef PG8_SB
#undef PG8_STAGE
#undef PG8_LDA
#undef PG8_LDB
#undef PG8_MMA
#undef PG8_WAIT_V
#undef PG8_WAIT_L
#undef PG8_BAR
#undef PG8_SCHED
}

typedef const f32x4 (&AccRef)[2][2][4][2];
#define EPI_ROWS for (int ai = 0; ai < 2; ++ai) for (int m = 0; m < 4; ++m)
__device__ __forceinline__ u32x4 pack8(f32x4 v0, f32x4 v1) { u32x4 w; w.x = cvt_pk_bf16(v0[0], v0[1]); w.y = cvt_pk_bf16(v0[2], v0[3]); w.z = cvt_pk_bf16(v1[0], v1[1]); w.w = cvt_pk_bf16(v1[2], v1[3]); return w; }
__device__ __forceinline__ void rope8(f32x4& v0, f32x4& v1, const float* cs) {
    const f32x4 t0 = *(const f32x4*)cs, t1 = *(const f32x4*)(cs + 4);
    f32x4 a = v0, b = v1;
    v0[0] = a[0] * t0[0] - a[1] * t0[1]; v0[1] = a[1] * t0[0] + a[0] * t0[1];
    v0[2] = a[2] * t0[2] - a[3] * t0[3]; v0[3] = a[3] * t0[2] + a[2] * t0[3];
    v1[0] = b[0] * t1[0] - b[1] * t1[1]; v1[1] = b[1] * t1[0] + b[0] * t1[1];
    v1[2] = b[2] * t1[2] - b[3] * t1[3]; v1[3] = b[3] * t1[2] + b[2] * t1[3];
}

struct EpiStore {
    bf16_t* O; int ldc;
    __device__ __forceinline__ void operator()(AccRef acc, const Unit& u, int wr, int wc, int fr, int fq) const {
        const int col0 = u.pn * BM + wc * 32 + 8 * fq;
#pragma unroll
        EPI_ROWS { const int row = u.pm * BM + ai * HALF + wr * 64 + m * 16 + fr; bf16_t* rowp = O + (size_t)row * ldc + col0;
#pragma unroll
            for (int bj = 0; bj < 2; ++bj) *(u32x4*)(rowp + bj * HALF) = pack8(acc[ai][bj][m][0], acc[ai][bj][m][1]); }
    }
};
struct EpiIn {
    bf16_t* Z1; bf16_t* KRb; float* rpart; const float* rope; int S;
    __device__ __forceinline__ void operator()(AccRef acc, const Unit& u, int wr, int wc, int fr, int fq) const {
        const int col0 = u.pn * BM + wc * 32 + 8 * fq;
        if (u.pn == 3) {
            if (wc < 2) {
#pragma unroll
                EPI_ROWS { const int row = u.pm * BM + ai * HALF + wr * 64 + m * 16 + fr; const int pos = row & (S - 1);
                    f32x4 v0 = acc[ai][0][m][0], v1 = acc[ai][0][m][1];
                    rope8(v0, v1, rope + ((size_t)pos * 32 + 16 * wc + 4 * fq) * 2);
                    *(u32x4*)(KRb + (size_t)row * 64 + 32 * wc + 8 * fq) = pack8(v0, v1); }
            }
            return;
        }
#pragma unroll
        EPI_ROWS { const int row = u.pm * BM + ai * HALF + wr * 64 + m * 16 + fr; bf16_t* rowp = Z1 + (size_t)row * NZ1 + col0;
            float s = 0.f;
#pragma unroll
            for (int bj = 0; bj < 2; ++bj) { const f32x4 v0 = acc[ai][bj][m][0], v1 = acc[ai][bj][m][1];
                s += (v0[0] * v0[0] + v0[1] * v0[1]) + (v0[2] * v0[2] + v0[3] * v0[3]) + (v1[0] * v1[0] + v1[1] * v1[1]) + (v1[2] * v1[2] + v1[3] * v1[3]);
                *(u32x4*)(rowp + bj * HALF) = pack8(v0, v1); }
            if (u.pn < 3) { s += __shfl_xor(s, 16); s += __shfl_xor(s, 32); if (fq == 0) rpart[(size_t)row * 12 + u.pn * 4 + wc] = s; }
        }
    }
};
struct EpiUT {
    bf16_t* UT; int S, lgS;
    __device__ __forceinline__ void operator()(AccRef acc, const Unit& u, int wr, int wc, int fr, int fq) const {
        const int col0 = u.pn * BM + wc * 32 + 8 * fq;
#pragma unroll
        EPI_ROWS { const int ch = u.pm * BM + ai * HALF + wr * 64 + m * 16 + fr;
#pragma unroll
            for (int bj = 0; bj < 2; ++bj) { const int tok = col0 + bj * HALF, b = tok >> lgS, pos = tok & (S - 1);
                *(u32x4*)(UT + ((size_t)(b * 512 + (ch & 511)) * 2 * S + (size_t)(ch >> 9) * S + pos)) = pack8(acc[ai][bj][m][0], acc[ai][bj][m][1]); } }
    }
};
struct EpiQ {
    bf16_t* Q; const float* rpart; const float* rope; int S;
    __device__ __forceinline__ void operator()(AccRef acc, const Unit& u, int wr, int wc, int fr, int fq) const {
        const int col0 = u.pn * BM + wc * 32 + 8 * fq;
#pragma unroll
        EPI_ROWS { const int row = u.pm * BM + ai * HALF + wr * 64 + m * 16 + fr; const int pos = row & (S - 1);
            const f32x4 p0 = *(const f32x4*)(rpart + (size_t)row * 12), p1 = *(const f32x4*)(rpart + (size_t)row * 12 + 4);
            const float r = __builtin_amdgcn_rsqf((((p0[0] + p0[1]) + (p0[2] + p0[3])) + ((p1[0] + p1[1]) + (p1[2] + p1[3]))) * (1.f / 512.f) + EPS);
#pragma unroll
            for (int bj = 0; bj < 2; ++bj) { const int col = col0 + bj * HALF, j = col % 192;
                f32x4 v0 = acc[ai][bj][m][0] * r, v1 = acc[ai][bj][m][1] * r;
                if (j >= 128) rope8(v0, v1, rope + ((size_t)pos * 32 + ((j - 128) >> 1)) * 2);
                *(u32x4*)(Q + (size_t)row * NQ + col) = pack8(v0, v1); } }
    }
};
struct EpiKV {
    bf16_t* KV; const float* rpart;
    __device__ __forceinline__ void operator()(AccRef acc, const Unit& u, int wr, int wc, int fr, int fq) const {
        const int col0 = u.pn * BM + wc * 32 + 8 * fq;
#pragma unroll
        EPI_ROWS { const int row = u.pm * BM + ai * HALF + wr * 64 + m * 16 + fr;
            const f32x4 p2 = *(const f32x4*)(rpart + (size_t)row * 12 + 8);
            const float r = __builtin_amdgcn_rsqf(((p2[0] + p2[1]) + (p2[2] + p2[3])) * (1.f / 256.f) + EPS);
#pragma unroll
            for (int bj = 0; bj < 2; ++bj) *(u32x4*)(KV + (size_t)row * NKV + col0 + bj * HALF) = pack8(acc[ai][bj][m][0] * r, acc[ai][bj][m][1] * r); }
    }
};
struct EpiDft {
    bf16_t* FO; int S; float scale;
    __device__ __forceinline__ void operator()(AccRef acc, const Unit& u, int wr, int wc, int fr, int fq) const {
        const int col0 = u.pn * BM + wc * 32 + 8 * fq;
#pragma unroll
        EPI_ROWS { const int row = u.bz * S + u.pm * BM + ai * HALF + wr * 64 + m * 16 + fr;
#pragma unroll
            for (int bj = 0; bj < 2; ++bj) *(u32x4*)(FO + (size_t)row * 512 + col0 + bj * HALF) = pack8(acc[ai][bj][m][0] * scale, acc[ai][bj][m][1] * scale); }
    }
};
template <bool ADD> struct EpiMerge {
    bf16_t* MG; const bf16_t* Z1; int goff;
    __device__ __forceinline__ void operator()(AccRef acc, const Unit& u, int wr, int wc, int fr, int fq) const {
        const int col0 = u.pn * BM + wc * 32 + 8 * fq;
#pragma unroll
        EPI_ROWS { const int row = u.pm * BM + ai * HALF + wr * 64 + m * 16 + fr;
#pragma unroll
            for (int bj = 0; bj < 2; ++bj) { const int col = col0 + bj * HALF;
                const u32x4 gw = *(const u32x4*)(Z1 + (size_t)row * NZ1 + goff + col);
                bf16_t* op = MG + (size_t)row * DM + col;
                f32x4 v0 = acc[ai][bj][m][0], v1 = acc[ai][bj][m][1];
                v0[0] *= sigmoidf_(bf_lo(gw.x)); v0[1] *= sigmoidf_(bf_hi(gw.x)); v0[2] *= sigmoidf_(bf_lo(gw.y)); v0[3] *= sigmoidf_(bf_hi(gw.y));
                v1[0] *= sigmoidf_(bf_lo(gw.z)); v1[1] *= sigmoidf_(bf_hi(gw.z)); v1[2] *= sigmoidf_(bf_lo(gw.w)); v1[3] *= sigmoidf_(bf_hi(gw.w));
                if (ADD) { const u32x4 pw = *(const u32x4*)op;
                    v0[0] += bf_lo(pw.x); v0[1] += bf_hi(pw.x); v0[2] += bf_lo(pw.y); v0[3] += bf_hi(pw.y);
                    v1[0] += bf_lo(pw.z); v1[1] += bf_hi(pw.z); v1[2] += bf_lo(pw.w); v1[3] += bf_hi(pw.w); }
                *(u32x4*)op = pack8(v0, v1); } }
    }
};
}

namespace att {
constexpr int NW = 8, QBLK = 32, KVBLK = 64;
constexpr float SCALE = 0.07216878364870322f;
constexpr float THR = 8.f;
constexpr int LDQ = NQ, LDK = NKV, LDKR = 64, LDO = DM;
constexpr int SHM_V = KVBLK * 128 * 2, SHM_K = KVBLK * 192 * 2, SHM_ATTN = 2 * SHM_V + 2 * SHM_K + NW * 64 * 4 + NW * 4096;
#define KSWZ(row, colB) ((row) * 384 + ((colB) ^ (((row) & 7) << 4)))
#define SBAR() __builtin_amdgcn_sched_barrier(0)
__device__ __forceinline__ int crow(int r, int hi) { return (r & 3) + 8 * (r >> 2) + 4 * hi; }
__device__ __forceinline__ unsigned cvtpk(float lo, float hi) { unsigned r; asm volatile("v_cvt_pk_bf16_f32 %0, %1, %2" : "=v"(r) : "v"(lo), "v"(hi)); return r; }
__device__ __forceinline__ bf16x8 ld8(const bf16_t* p) { return *reinterpret_cast<const bf16x8*>(p); }

__device__ __forceinline__ void partialSM(f32x16& p0, f32x16& p1, float& m_reg, float& mn, float& alpha) {
  constexpr float C = SCALE * 1.4426950408889634f;
  float pmax = p0[0];
#pragma unroll
  for (int r = 1; r < 16; ++r) pmax = fmaxf(pmax, p0[r]);
#pragma unroll
  for (int r = 0; r < 16; ++r) pmax = fmaxf(pmax, p1[r]);
  { auto rr = __builtin_amdgcn_permlane32_swap(__float_as_uint(pmax), __float_as_uint(pmax), false, false);
    pmax = fmaxf(__uint_as_float(rr[0]), __uint_as_float(rr[1])); }
  if (__builtin_expect(__all(pmax - m_reg <= THR / SCALE), 1)) { mn = m_reg; alpha = 1.f; }
  else { mn = fmaxf(m_reg, pmax); alpha = __builtin_amdgcn_exp2f((m_reg - mn) * C); m_reg = mn; }
  float mnC = -mn * C;
#pragma unroll
  for (int r = 0; r < 16; ++r) p0[r] = fmaf(p0[r], C, mnC);
#pragma unroll
  for (int r = 0; r < 16; ++r) p1[r] = fmaf(p1[r], C, mnC);
#pragma unroll
  for (int r = 0; r < 16; ++r) p0[r] = __builtin_amdgcn_exp2f(p0[r]);
}
__device__ __forceinline__ void finishSM(f32x16& p0, f32x16& p1, float alpha, float& l_reg, bf16x8& pa0, bf16x8& pa1, bf16x8& pa2, bf16x8& pa3) {
#pragma unroll
  for (int r = 0; r < 16; ++r) p1[r] = __builtin_amdgcn_exp2f(p1[r]);
  float ps = 0;
#pragma unroll
  for (int r = 0; r < 16; ++r) ps += p0[r];
#pragma unroll
  for (int r = 0; r < 16; ++r) ps += p1[r];
  { auto rr = __builtin_amdgcn_permlane32_swap(__float_as_uint(ps), __float_as_uint(ps), false, false);
    ps = __uint_as_float(rr[0]) + __uint_as_float(rr[1]); }
  l_reg = l_reg * alpha + ps;
#define PK4(P, BASE, OUT) do { unsigned a0 = cvtpk(P[BASE + 0], P[BASE + 1]), a1 = cvtpk(P[BASE + 2], P[BASE + 3]);   \
    unsigned b0 = cvtpk(P[BASE + 4], P[BASE + 5]), b1 = cvtpk(P[BASE + 6], P[BASE + 7]);                              \
    auto r0 = __builtin_amdgcn_permlane32_swap(a0, b0, false, false); auto r1 = __builtin_amdgcn_permlane32_swap(a1, b1, false, false); \
    u32x4 w = {r0[0], r1[0], r0[1], r1[1]}; OUT = *reinterpret_cast<bf16x8*>(&w); } while (0)
  PK4(p0, 0, pa0); PK4(p0, 8, pa1); PK4(p1, 0, pa2); PK4(p1, 8, pa3);
#undef PK4
}
__device__ __forceinline__ void qkt(f32x16& p0, f32x16& p1, const char* Ks, const bf16x8* qr, const char* qrl, int r32, int hi) {
  p0 = f32x16{}; p1 = f32x16{};
#pragma unroll
  for (int d0 = 0; d0 < 12; ++d0) { int cb = (d0 * 16 + hi * 8) * 2;
    bf16x8 b0 = *reinterpret_cast<const bf16x8*>(Ks + KSWZ(r32, cb));
    bf16x8 b1 = *reinterpret_cast<const bf16x8*>(Ks + KSWZ(32 + r32, cb));
    const bf16x8 qf = d0 < 8 ? qr[d0 & 7] : *reinterpret_cast<const bf16x8*>(qrl + (d0 - 8) * 1024);
    p0 = __builtin_amdgcn_mfma_f32_32x32x16_bf16(b0, qf, p0, 0, 0, 0);
    p1 = __builtin_amdgcn_mfma_f32_32x32x16_bf16(b1, qf, p1, 0, 0, 0); }
}
__device__ __forceinline__ int v_st(int k, int c) { const int kk = (k & ~0xC) | ((k & 4) << 1) | ((k & 8) >> 1); return ((kk >> 3) * 4 + (c >> 5)) * 512 + ((kk & 7) * 32 + (c & 31)) * 2; }
__device__ __forceinline__ int v_rd_base(int lane) { return ((lane & 3) << 3) | (((lane >> 2) & 3) << 6) | (((lane >> 4) & 1) << 5) | (((lane >> 5) & 1) << 8); }
constexpr int v_rd_off(int d0, int ks, int half) { return d0 * 512 + ks * 4096 + half * 2048; }
template <int OFF> __device__ __forceinline__ s16x4 tr_read(int vb) {
  s16x4 r; asm volatile("ds_read_b64_tr_b16 %0, %1 offset:%2" : "=&v"(r) : "v"(vb), "i"(OFF) : "memory"); return r;
}
template <int D0> __device__ __forceinline__ void pv_one(f32x16& od, int vb, bf16x8 pa0, bf16x8 pa1, bf16x8 pa2, bf16x8 pa3) {
  const s16x4 l0 = tr_read<v_rd_off(D0, 0, 0)>(vb), h0 = tr_read<v_rd_off(D0, 0, 1)>(vb), l1 = tr_read<v_rd_off(D0, 1, 0)>(vb), h1 = tr_read<v_rd_off(D0, 1, 1)>(vb);
  const s16x4 l2 = tr_read<v_rd_off(D0, 2, 0)>(vb), h2 = tr_read<v_rd_off(D0, 2, 1)>(vb), l3 = tr_read<v_rd_off(D0, 3, 0)>(vb), h3 = tr_read<v_rd_off(D0, 3, 1)>(vb);
  asm volatile("s_waitcnt lgkmcnt(0)" ::: "memory"); SBAR();
#define PK(L, H) (bf16x8){L[0], L[1], L[2], L[3], H[0], H[1], H[2], H[3]}
  od = __builtin_amdgcn_mfma_f32_32x32x16_bf16(pa0, PK(l0, h0), od, 0, 0, 0);
  od = __builtin_amdgcn_mfma_f32_32x32x16_bf16(pa1, PK(l1, h1), od, 0, 0, 0);
  od = __builtin_amdgcn_mfma_f32_32x32x16_bf16(pa2, PK(l2, h2), od, 0, 0, 0);
  od = __builtin_amdgcn_mfma_f32_32x32x16_bf16(pa3, PK(l3, h3), od, 0, 0, 0);
#undef PK
}
__device__ __forceinline__ void pv_d0(f32x16* o, int vb, bf16x8 pa0, bf16x8 pa1, bf16x8 pa2, bf16x8 pa3) {
  pv_one<0>(o[0], vb, pa0, pa1, pa2, pa3); pv_one<1>(o[1], vb, pa0, pa1, pa2, pa3); pv_one<2>(o[2], vb, pa0, pa1, pa2, pa3); pv_one<3>(o[3], vb, pa0, pa1, pa2, pa3);
}

__device__ __forceinline__ void attn_unit(const bf16_t* __restrict__ Qb, const bf16_t* __restrict__ Kh, const bf16_t* __restrict__ Vh, const bf16_t* __restrict__ Kr,
                                          bf16_t* __restrict__ Ob, int seq, char* lds) {
  int tid_ = threadIdx.x; asm volatile("" : "+v"(tid_));
  const int tid = tid_, wid = tid >> 6, lane = tid & 63, r32 = lane & 31, hi = lane >> 5;
  char* V_lds = lds; char* K_lds = lds + 2 * SHM_V;
  float* ws = (float*)(lds + 2 * SHM_V + 2 * SHM_K) + wid * 64; float* li_l = ws; float* al_l = ws + 32;
  float m_reg = -1e30f, l_reg = 0; f32x16 o[4] = {}; bf16x8 qr[8];
  char* qrl = lds + 2 * SHM_V + 2 * SHM_K + NW * 64 * 4 + wid * 4096 + lane * 16;
  const bf16_t* Qw = Qb + (long)(wid * QBLK + r32) * LDQ + hi * 8;
#pragma unroll
  for (int d0 = 0; d0 < 8; ++d0) qr[d0] = ld8(Qw + d0 * 16);
#pragma unroll
  for (int d0 = 8; d0 < 12; ++d0) *reinterpret_cast<bf16x8*>(qrl + (d0 - 8) * 1024) = ld8(Qw + d0 * 16);
  const int sr = tid >> 4, sc = (tid & 15) * 8, vst0 = v_st(sr, sc), vst1 = v_st(32 + sr, sc);
  const int krr = tid >> 3, krc = (tid & 7) * 8;
  const int vb0 = (int)(uintptr_t)V_lds + v_rd_base(lane);
  bf16x8 vs0, vs1, ks0, ks1, kr0;
#define SLOAD(k0) do { vs0 = ld8(&Vh[(long)((k0) + sr) * LDK + sc]); vs1 = ld8(&Vh[(long)((k0) + 32 + sr) * LDK + sc]); \
    ks0 = ld8(&Kh[(long)((k0) + sr) * LDK + sc]); ks1 = ld8(&Kh[(long)((k0) + 32 + sr) * LDK + sc]); kr0 = ld8(&Kr[(long)((k0) + krr) * LDKR + krc]); } while (0)
#define SWRITE(b) do { *(bf16x8*)(V_lds + (b) * SHM_V + vst0) = vs0; *(bf16x8*)(V_lds + (b) * SHM_V + vst1) = vs1; int kc = sc * 2; \
    *(bf16x8*)(K_lds + (b) * SHM_K + KSWZ(sr, kc)) = ks0; *(bf16x8*)(K_lds + (b) * SHM_K + KSWZ(32 + sr, kc)) = ks1; \
    *(bf16x8*)(K_lds + (b) * SHM_K + KSWZ(krr, 256 + krc * 2)) = kr0; } while (0)
#define SWAIT() asm volatile("s_waitcnt vmcnt(0)" ::: "memory")
#define RESC(a) do { if (__any((a) < 1.f)) { if (hi == 0) al_l[r32] = (a); asm volatile("s_waitcnt lgkmcnt(0)" ::: "memory"); \
    _Pragma("unroll") for (int d = 0; d < 4; ++d) _Pragma("unroll") for (int r = 0; r < 16; ++r) o[d][r] *= al_l[crow(r, hi)]; } } while (0)
  f32x16 pA0, pA1, pB0, pB1; float mnA, mnB, alA, alB; bf16x8 pa0, pa1, pa2, pa3; const int NT = seq / KVBLK;
  SLOAD(0); SWAIT(); SWRITE(0); __syncthreads();
  qkt(pA0, pA1, K_lds, qr, qrl, r32, hi); partialSM(pA0, pA1, m_reg, mnA, alA);
  SLOAD(KVBLK);
  SWAIT(); SWRITE(1); __syncthreads();
  for (int j = 1; j + 1 < NT; j += 2) {
    SBAR(); qkt(pB0, pB1, K_lds + SHM_K, qr, qrl, r32, hi);
    finishSM(pA0, pA1, alA, l_reg, pa0, pa1, pa2, pa3); SBAR();
    SLOAD((j + 1) * KVBLK); SBAR();
    pv_d0(o, vb0, pa0, pa1, pa2, pa3); partialSM(pB0, pB1, m_reg, mnB, alB);
    __syncthreads(); SWAIT(); SWRITE(0);
    RESC(alB); __syncthreads();
    SBAR(); qkt(pA0, pA1, K_lds, qr, qrl, r32, hi);
    finishSM(pB0, pB1, alB, l_reg, pa0, pa1, pa2, pa3); SBAR();
    SLOAD((j + 2) * KVBLK); SBAR();
    pv_d0(o, vb0 + SHM_V, pa0, pa1, pa2, pa3); partialSM(pA0, pA1, m_reg, mnA, alA);
    __syncthreads(); SWAIT(); SWRITE(1);
    RESC(alA); __syncthreads();
  }
  SBAR(); qkt(pB0, pB1, K_lds + SHM_K, qr, qrl, r32, hi);
  finishSM(pA0, pA1, alA, l_reg, pa0, pa1, pa2, pa3); SBAR();
  pv_d0(o, vb0, pa0, pa1, pa2, pa3); partialSM(pB0, pB1, m_reg, mnB, alB);
  __syncthreads(); RESC(alB);
  finishSM(pB0, pB1, alB, l_reg, pa0, pa1, pa2, pa3); SBAR();
  pv_d0(o, vb0 + SHM_V, pa0, pa1, pa2, pa3);
  if (hi == 0) li_l[r32] = l_reg; asm volatile("s_waitcnt lgkmcnt(0)" ::: "memory");
  float rli[16];
#pragma unroll
  for (int r = 0; r < 16; ++r) rli[r] = __builtin_amdgcn_rcpf(li_l[crow(r, hi)]);
  bf16_t* Ow = Ob + (long)(wid * QBLK) * LDO;
#pragma unroll
  for (int r = 0; r < 16; ++r) { int orow = crow(r, hi);
#pragma unroll
    for (int d0 = 0; d0 < 4; ++d0) Ow[(long)orow * LDO + d0 * 32 + r32] = (bf16_t)f2bf(o[d0][r] * rli[r]); }
#undef SLOAD
#undef SWRITE
#undef SWAIT
#undef RESC
}
}

#define XB_TMO      128
#define XB_XCNT(j)  (256  + 64 * (j))
#define XB_XSUB(j)  (1280 + 64 * (j))
#define XB_XGEN(j)  (2304 + 64 * (j))
#define XB_TOP      3328
#define XB_TOPGEN   3392
#define XCD_BAR_WORDS 3456
#define XB_SPIN_CAP (1u << 18)

__device__ __forceinline__ unsigned xb_ld(unsigned* p)              { return __hip_atomic_load(p, __ATOMIC_RELAXED, __HIP_MEMORY_SCOPE_AGENT); }
__device__ __forceinline__ unsigned xb_add(unsigned* p, unsigned v) { return __hip_atomic_fetch_add(p, v, __ATOMIC_RELAXED, __HIP_MEMORY_SCOPE_AGENT); }
__device__ __forceinline__ unsigned xb_xcc_id() { return (unsigned)__builtin_amdgcn_s_getreg((3 << 11) | 20) & 0xFu; }
#define XB_SPIN(cond, bar) do { unsigned _sp = 0; while (cond) { __builtin_amdgcn_s_sleep(1); \
    if ((++_sp & 255u) == 0u) { if (xb_ld(&(bar)[XB_TMO])) break; if (_sp > XB_SPIN_CAP) { atomicAdd(&(bar)[XB_TMO], 1u); break; } } } } while (0)

struct XcdBarrier {
    unsigned* bar; unsigned x;
    volatile LAS unsigned* st;
};

__device__ __forceinline__ XcdBarrier xcd_barrier_post(unsigned* bar, volatile LAS unsigned* st) {
    XcdBarrier b; b.bar = bar; b.x = xb_xcc_id(); b.st = st;
    if (threadIdx.x == 0) (void)xb_add(&bar[XB_XCNT(b.x)], 1u);
    return b;
}
__device__ __forceinline__ void xcd_barrier_complete(unsigned* bar, unsigned x, unsigned& nloc, unsigned& nx) {
    const unsigned G = gridDim.x * gridDim.y * gridDim.z;
    unsigned sum, cnt, mine, sp = 0u;
    for (;;) {
        sum = 0u; cnt = 0u; mine = 0u;
#pragma unroll
        for (unsigned j = 0; j < 16; ++j) { const unsigned c = xb_ld(&bar[XB_XCNT(j)]); sum += c; cnt += (c > 0u) ? 1u : 0u; mine = (j == x) ? c : mine; }
        if (sum == G) break;
        __builtin_amdgcn_s_sleep(1);
        if ((++sp & 255u) == 0u) { if (xb_ld(&bar[XB_TMO])) break; if (sp > XB_SPIN_CAP) { atomicAdd(&bar[XB_TMO], 1u); break; } }
    }
    nloc = mine > 0u ? mine : 1u; nx = cnt > 0u ? cnt : 1u;
}

__device__ __forceinline__ void xcd_barrier(const XcdBarrier& b) {
    asm volatile("s_waitcnt vmcnt(0)" ::: "memory");
    __syncthreads();
    if (threadIdx.x == 0) {
        unsigned* bar = b.bar;
        __builtin_amdgcn_s_waitcnt(0);
        unsigned nloc = b.st[0], nx = b.st[1];
        if (nloc == 0u) { xcd_barrier_complete(bar, b.x, nloc, nx); b.st[0] = nloc; b.st[1] = nx; }
        const unsigned old = xb_add(&bar[XB_XSUB(b.x)], 1u);
        const unsigned gen = old / nloc;
        if (old + 1u == (gen + 1u) * nloc) {
            __builtin_amdgcn_fence(__ATOMIC_RELEASE, "agent");
            asm volatile("s_waitcnt vmcnt(0)" ::: "memory");
            const unsigned og = xb_add(&bar[XB_TOP], 1u);
            const unsigned tg = og / nx;
            if (og + 1u == (tg + 1u) * nx) xb_add(&bar[XB_TOPGEN], 1u);
            else XB_SPIN(xb_ld(&bar[XB_TOPGEN]) == tg, bar);
            __builtin_amdgcn_fence(__ATOMIC_ACQUIRE, "agent");
            xb_add(&bar[XB_XGEN(b.x)], 1u);
            asm volatile("s_waitcnt vmcnt(0)" ::: "memory");
        } else {
            XB_SPIN(xb_ld(&bar[XB_XGEN(b.x)]) == gen, bar);
            __builtin_amdgcn_fence(__ATOMIC_ACQUIRE, "agent");
            asm volatile("s_waitcnt vmcnt(0)" ::: "memory");
        }
    }
    __syncthreads();
}


struct Args { const float* in[22]; float* out; unsigned char* ws; };
#define CAS __attribute__((address_space(4)))
__device__ __forceinline__ const void* karg(int byte_off) {
    const char CAS* kp = (const char CAS*)__builtin_amdgcn_kernarg_segment_ptr();
    asm volatile("" : "+s"(kp));
    return *(const void* const CAS*)(kp + byte_off);
}
#define KARG(i) ((const float*)karg(8 * (i)))
#define KOUT ((float*)karg(176))
#define KWS ((unsigned char*)karg(184))

enum { I_XP = 0, I_XS, I_CP, I_CS, I_WADA, I_BADA, I_GMPRE, I_GMPOST, I_WIN, I_GQ, I_WQB, I_GKV, I_WKVB, I_WAO, I_WFOUR, I_WOUT, I_GFPRE, I_GFPOST, I_WUP, I_WCONV, I_BCONV, I_WDOWN };

__device__ __forceinline__ int colmap(int kind, int n) {
    if (kind == 0) return n;
    if (kind == 1) {
        if (n < 768) return n;
        if (n < 832) { const int j = n - 768; return OFF_KR + (j >> 1) + ((j & 1) << 5); }
        if (n < 1024) return -1;
        return OFF_G + (n - 1024);
    }
    const int hh = n / 192, j = n % 192;
    if (j < 128) return n;
    const int jj = j - 128; return hh * 192 + 128 + (jj >> 1) + ((jj & 1) << 5);
}
__device__ __forceinline__ void transpose_item(const float* W, int ld, int K, int Nn, bf16_t* WT, int kind, const float* g, LAS float* scr, int item, int lane) {
    const int nblk = Nn / 32, kb = item / nblk, nb = item % nblk, k0 = 64 * kb, n0 = 32 * nb;
    const int sc = colmap(kind, n0 + (lane & 31));
#pragma unroll 8
    for (int i = 0; i < 32; ++i) { const int kk = 2 * i + (lane >> 5); float v = sc >= 0 ? W[(size_t)(k0 + kk) * ld + sc] : 0.f; if (g) v *= g[k0 + kk]; scr[kk * 33 + (lane & 31)] = v; }
    asm volatile("s_waitcnt lgkmcnt(0)" ::: "memory");
    const int c = lane & 7;
#pragma unroll
    for (int j = 0; j < 4; ++j) { const int n = (lane >> 3) + 8 * j; const LAS float* s = scr + (8 * c) * 33 + n;
        u32x4 o; o.x = pk2(s[0 * 33], s[1 * 33]); o.y = pk2(s[2 * 33], s[3 * 33]); o.z = pk2(s[4 * 33], s[5 * 33]); o.w = pk2(s[6 * 33], s[7 * 33]);
        *(u32x4*)(WT + (size_t)(n0 + n) * K + k0 + 8 * c) = o; }
    asm volatile("s_waitcnt lgkmcnt(0)" ::: "memory");
}

__device__ __forceinline__ void row_phase(const float* xin, float* xout, const bf16_t* y, const float* gpost, int gt_off, const float* gpre, int sc_off, int sh_off,
                                          bf16_t* hout, const float* modg, const float* modh, int bg0, int lgS, float* z0, float* z1, int gw, int NGW, int lane) {
    for (int t = gw; t < T; t += NGW) {
        const float* mrow = modh + (size_t)(bg0 + (t >> lgS)) * 6144;
        const float* grow = modg + (size_t)(bg0 + (t >> lgS)) * 6144;
        const f32x4* xr = (const f32x4*)(xin + (size_t)t * DM) + lane;
        f32x4 v[4];
#pragma unroll
        for (int j = 0; j < 4; ++j) v[j] = xr[64 * j];
        if (y) {
            const u32x2* yr = (const u32x2*)(y + (size_t)t * DM) + lane;
            f32x4 yv[4]; float s = 0.f;
#pragma unroll
            for (int j = 0; j < 4; ++j) { const u32x2 w = yr[64 * j]; yv[j] = (f32x4){bf_lo(w.x), bf_hi(w.x), bf_lo(w.y), bf_hi(w.y)};
                s += (yv[j][0] * yv[j][0] + yv[j][1] * yv[j][1]) + (yv[j][2] * yv[j][2] + yv[j][3] * yv[j][3]); }
            const float rs = __builtin_amdgcn_rsqf(wave_sum(s) * (1.f / DM) + EPS);
            f32x4* xo = (f32x4*)(xout + (size_t)t * DM) + lane;
#pragma unroll
            for (int j = 0; j < 4; ++j) { const f32x4 gp = *((const f32x4*)gpost + lane + 64 * j), gt = *((const f32x4*)(grow + gt_off) + lane + 64 * j);
                v[j] = v[j] + gt * (yv[j] * rs * gp); xo[64 * j] = v[j]; }
        }
        if (hout) {
            float s = 0.f;
#pragma unroll
            for (int j = 0; j < 4; ++j) s += (v[j][0] * v[j][0] + v[j][1] * v[j][1]) + (v[j][2] * v[j][2] + v[j][3] * v[j][3]);
            const float rs = __builtin_amdgcn_rsqf(wave_sum(s) * (1.f / DM) + EPS);
            u32x2* ho = (u32x2*)(hout + (size_t)t * DM) + lane;
#pragma unroll
            for (int j = 0; j < 4; ++j) { const f32x4 gp = *((const f32x4*)gpre + lane + 64 * j), sc = *((const f32x4*)(mrow + sc_off) + lane + 64 * j), sh = *((const f32x4*)(mrow + sh_off) + lane + 64 * j);
                const f32x4 h = (v[j] * rs * gp) * (sc + 1.f) + sh; u32x2 w; w.x = pk2(h[0], h[1]); w.y = pk2(h[2], h[3]); ho[64 * j] = w; }
        }
        if (z0 && lane == 0) { z0[t] = 0.f; z1[t] = 0.f; }
    }
}

__device__ __forceinline__ float gelu_tanh(float a) {
    const float z = 1.5957691216057308f * (a + 0.044715f * a * a * a);
    return __fdividef(a, 1.f + __expf(-z));
}
__device__ __forceinline__ void conv_phase(const bf16_t* UP, bf16_t* ACT, const float* wconv, const float* bconv, int S, int gtid, int nthreads) {
    constexpr int NJB = DFF / 8;
    for (int idx = gtid; idx < (T / 8) * NJB; idx += nthreads) {
        const int jb = idx % NJB, tb = idx / NJB, j0 = jb * 8, t0 = tb * 8, pos0 = t0 & (S - 1);
        float wa[3][8], wb[3][8], ba[8], bb[8];
#pragma unroll
        for (int q = 0; q < 3; ++q)
#pragma unroll
            for (int e = 0; e < 8; e += 4) { const f32x4 a = *(const f32x4*)(wconv + q * NUP + j0 + e), b = *(const f32x4*)(wconv + q * NUP + DFF + j0 + e);
                wa[q][e] = a[0]; wa[q][e + 1] = a[1]; wa[q][e + 2] = a[2]; wa[q][e + 3] = a[3]; wb[q][e] = b[0]; wb[q][e + 1] = b[1]; wb[q][e + 2] = b[2]; wb[q][e + 3] = b[3]; }
#pragma unroll
        for (int e = 0; e < 8; e += 4) { const f32x4 a = *(const f32x4*)(bconv + j0 + e), b = *(const f32x4*)(bconv + DFF + j0 + e);
            ba[e] = a[0]; ba[e + 1] = a[1]; ba[e + 2] = a[2]; ba[e + 3] = a[3]; bb[e] = b[0]; bb[e + 1] = b[1]; bb[e + 2] = b[2]; bb[e + 3] = b[3]; }
        const u32x4 zero4 = {0u, 0u, 0u, 0u};
        const bf16_t* base = UP + (size_t)t0 * NUP + j0;
        u32x4 pa = zero4, pb = zero4, ca, cb, na, nb;
        if (pos0 > 0) { pa = *(const u32x4*)(base - NUP); pb = *(const u32x4*)(base - NUP + DFF); }
        ca = *(const u32x4*)base; cb = *(const u32x4*)(base + DFF);
#pragma unroll
        for (int i = 0; i < 8; ++i) {
            if (pos0 + i + 1 < S) { na = *(const u32x4*)(base + (size_t)(i + 1) * NUP); nb = *(const u32x4*)(base + (size_t)(i + 1) * NUP + DFF); } else { na = zero4; nb = zero4; }
            float r[8];
#pragma unroll
            for (int e = 0; e < 8; ++e) {
                const unsigned wpa = pa[e >> 1], wca = ca[e >> 1], wna = na[e >> 1], wpb = pb[e >> 1], wcb = cb[e >> 1], wnb = nb[e >> 1];
                const float xa0 = (e & 1) ? bf_hi(wpa) : bf_lo(wpa), xa1 = (e & 1) ? bf_hi(wca) : bf_lo(wca), xa2 = (e & 1) ? bf_hi(wna) : bf_lo(wna);
                const float xb0 = (e & 1) ? bf_hi(wpb) : bf_lo(wpb), xb1 = (e & 1) ? bf_hi(wcb) : bf_lo(wcb), xb2 = (e & 1) ? bf_hi(wnb) : bf_lo(wnb);
                const float va = xa0 * wa[0][e] + xa1 * wa[1][e] + xa2 * wa[2][e] + ba[e];
                const float vb = xb0 * wb[0][e] + xb1 * wb[1][e] + xb2 * wb[2][e] + bb[e];
                r[e] = gelu_tanh(va) * vb;
            }
            u32x4 o; o.x = pk2(r[0], r[1]); o.y = pk2(r[2], r[3]); o.z = pk2(r[4], r[5]); o.w = pk2(r[6], r[7]);
            *(u32x4*)(ACT + (size_t)(t0 + i) * DFF + j0) = o;
            pa = ca; pb = cb; ca = na; cb = nb;
        }
    }
}

__global__ void __launch_bounds__(512, 2) fwd_megakernel(Args args) {
#define PH_ENTER() \
    unsigned char* ws = KWS; \
    int bx = blockIdx.x; asm volatile("" : "+s"(bx)); int G = gridDim.x; asm volatile("" : "+s"(G)); \
    int tid = threadIdx.x; asm volatile("" : "+v"(tid)); \
    const int lane = tid & 63, wave = __builtin_amdgcn_readfirstlane(tid >> 6); \
    const int gw = bx * 8 + wave, NGW = G * 8, gtid = bx * 512 + tid, NT_ALL = G * 512; \
    (void)lane; (void)wave; (void)gw; (void)NGW; (void)gtid; (void)NT_ALL;
#define WSP(T_, off) ((T_*)(ws + (off)))
    extern __shared__ __attribute__((aligned(16))) unsigned char lds_raw[];
    cg::grid_group grid = cg::this_grid();
    LAS unsigned char* lds = (LAS unsigned char*)lds_raw;
    volatile LAS unsigned* MISC = (volatile LAS unsigned*)(lds + 131072 + 64);
    if (threadIdx.x < 2) MISC[threadIdx.x] = 0u;
    __syncthreads();
    (void)xcd_barrier_post((unsigned*)KWS, MISC);
#define GSYNC() do { XcdBarrier xb_; xb_.bar = (unsigned*)KWS; xb_.x = xb_xcc_id(); xb_.st = (volatile LAS unsigned*)((LAS unsigned char*)lds_raw + 131072 + 64); xcd_barrier(xb_); } while (0)
    {
    PH_ENTER();
    float* rope = WSP(float, WS_ROPE); float* mod = WSP(float, WS_MOD); bf16_t* Wb = WSP(bf16_t, WS_W); bf16_t* D2 = WSP(bf16_t, WS_D2); bf16_t* D4 = WSP(bf16_t, WS_D4);
    {
        for (int it = bx; it < DEPTH * 16 * 4; it += G) {
            const int l = it >> 6, kb = (it >> 2) & 15, g = it & 3, k0 = kb * 64;
            LAS float* tile = (LAS float*)lds;
            LAS float* cs = (LAS float*)(lds + 64 * 129 * 4);
            const float* Wsrc = KARG(I_WIN) + (size_t)l * DM * INW;
            for (int e = tid; e < 64 * 128; e += 512) { const int kk = e >> 7, c = e & 127; tile[kk * 129 + c] = Wsrc[(size_t)(k0 + kk) * INW + OFF_F + g * 128 + c]; }
            if (tid < 128) { const float rev = (float)tid * (1.f / 128.f); cs[2 * tid] = __builtin_amdgcn_cosf(rev); cs[2 * tid + 1] = __builtin_amdgcn_sinf(rev); }
            __syncthreads();
            const int k = lane, cp0 = wave * 16;
            float aC[16], aS[16];
#pragma unroll
            for (int j = 0; j < 16; ++j) { aC[j] = 0.f; aS[j] = 0.f; }
            for (int c = 0; c < 128; ++c) { const float x = tile[k * 129 + c];
#pragma unroll
                for (int j = 0; j < 16; ++j) { const int idx = (c * (cp0 + j)) & 127; aC[j] += x * cs[2 * idx]; aS[j] += x * cs[2 * idx + 1]; } }
            bf16_t* WF = Wb + (size_t)l * W_LAYER + W_F;
#pragma unroll
            for (int j = 0; j < 16; ++j) { WF[(size_t)(g * 128 + cp0 + j) * DM + k0 + k] = (bf16_t)f2bf(aC[j]); WF[(size_t)(512 + g * 128 + cp0 + j) * DM + k0 + k] = (bf16_t)f2bf(aS[j]); }
            __syncthreads();
        }
        for (int it = bx; it < DEPTH * 12; it += G) {
            const int l = it / 12, col = (it % 12) * 512 + tid;
            LAS float* sl = (LAS float*)lds;
            float acc[NB_ALL];
#pragma unroll
            for (int b = 0; b < NB_ALL; ++b) acc[b] = 0.f;
            const float* Wa = KARG(I_WADA) + (size_t)l * DM * 6144;
            for (int kc = 0; kc < 16; ++kc) {
                __syncthreads();
                for (int e = tid; e < 64 * NB_ALL; e += 512) { const int kk = e & 63, b = e >> 6;
                    const float v = b < 32 ? KARG(I_CP)[b * DM + kc * 64 + kk] : KARG(I_CS)[(b - 32) * DM + kc * 64 + kk];
                    sl[kk * NB_ALL + b] = v * sigmoidf_(v); }
                __syncthreads();
                for (int kq = 0; kq < 64; kq += 16) { float wv16[16];
#pragma unroll
                    for (int q = 0; q < 16; ++q) wv16[q] = Wa[(size_t)(kc * 64 + kq + q) * 6144 + col];
#pragma unroll
                    for (int q = 0; q < 16; ++q) { const float wv = wv16[q]; const int kk = kq + q;
#pragma unroll
                        for (int b = 0; b < NB_ALL; b += 4) { const f32x4 s4 = *(const LAS f32x4*)(sl + kk * NB_ALL + b); acc[b] += s4[0] * wv; acc[b + 1] += s4[1] * wv; acc[b + 2] += s4[2] * wv; acc[b + 3] += s4[3] * wv; } } }
            }
            const float bias = KARG(I_BADA)[l * 6144 + col];
#pragma unroll
            for (int b = 0; b < NB_ALL; ++b) mod[(size_t)(l * NB_ALL + b) * 6144 + col] = acc[b] + bias;
            __syncthreads();
        }
        {
            LAS float* scr = (LAS float*)(lds + wave * 16384);
            constexpr int NI0 = 1536, NI1 = 384, NI2 = 256, NI3 = 512, NI4 = 256, NI5 = 512, NI6 = 2816, NI7 = 1408, NIL = NI0 + NI1 + NI2 + NI3 + NI4 + NI5 + NI6 + NI7;
            for (int it = gw; it < DEPTH * NIL; it += NGW) {
                const int l = it / NIL; int r = it % NIL; bf16_t* WL = Wb + (size_t)l * W_LAYER;
                if (r < NI0) { transpose_item(KARG(I_WIN) + (size_t)l * DM * INW, INW, 1024, NZ1, WL + W_IN, 1, nullptr, scr, r, lane); continue; } r -= NI0;
                if (r < NI1) { transpose_item(KARG(I_WQB) + (size_t)l * 512 * NQ, NQ, 512, NQ, WL + W_QB, 2, KARG(I_GQ) + l * 512, scr, r, lane); continue; } r -= NI1;
                if (r < NI2) { transpose_item(KARG(I_WKVB) + (size_t)l * 256 * NKV, NKV, 256, NKV, WL + W_KVB, 0, KARG(I_GKV) + l * 256, scr, r, lane); continue; } r -= NI2;
                if (r < NI3) { transpose_item(KARG(I_WAO) + (size_t)l * DM * DM, DM, 1024, DM, WL + W_AO, 0, nullptr, scr, r, lane); continue; } r -= NI3;
                if (r < NI4) { transpose_item(KARG(I_WFOUR) + (size_t)l * 512 * DM, DM, 512, DM, WL + W_FOUR, 0, nullptr, scr, r, lane); continue; } r -= NI4;
                if (r < NI5) { transpose_item(KARG(I_WOUT) + (size_t)l * DM * DM, DM, 1024, DM, WL + W_OUT, 0, nullptr, scr, r, lane); continue; } r -= NI5;
                if (r < NI6) { transpose_item(KARG(I_WUP) + (size_t)l * DM * NUP, NUP, 1024, NUP, WL + W_UP, 0, nullptr, scr, r, lane); continue; } r -= NI6;
                transpose_item(KARG(I_WDOWN) + (size_t)l * DFF * DM, DM, DFF, DM, WL + W_DOWN, 0, nullptr, scr, r, lane);
            }
        }
        for (int sel = 0; sel < 2; ++sel) {
            const int S = sel ? 4096 : 2048, lg = sel ? 12 : 11; bf16_t* Dm = sel ? D4 : D2;
            const int per_row = 2 * S / 8, nitems = S * per_row; const float inv = 1.f / (float)S;
            for (int it = gtid; it < nitems; it += NT_ALL) {
                const int sp = it / per_row, k8 = (it % per_row) * 8; const bool isSin = k8 >= S; const int kbase = k8 & (S - 1);
                float v[8];
#pragma unroll
                for (int e = 0; e < 8; ++e) { const float rev = (float)((sp * (kbase + e)) & (S - 1)) * inv; v[e] = isSin ? -__builtin_amdgcn_sinf(rev) : __builtin_amdgcn_cosf(rev); }
                u32x4 o; o.x = pk2(v[0], v[1]); o.y = pk2(v[2], v[3]); o.z = pk2(v[4], v[5]); o.w = pk2(v[6], v[7]);
                *(u32x4*)(Dm + ((size_t)sp << (lg + 1)) + k8) = o;
            }
        }
        for (int it = gtid; it < 4096 * 32; it += NT_ALL) {
            const int pos = it >> 5, i = it & 31;
            const float invf = __builtin_amdgcn_exp2f(-(float)i * (13.287712379549449f / 32.f));
            const float ang = (float)pos * invf;
            const float n = rintf(ang * 0.15915494309189535f);
            float r = fmaf(-n, 6.2831855f, ang); r = fmaf(n, 1.7484556e-7f, r);
            const float rev = r * 0.15915494309189535f;
            rope[2 * it] = __builtin_amdgcn_cosf(rev); rope[2 * it + 1] = __builtin_amdgcn_sinf(rev);
        }
    }
    }
    grid.sync();

    for (int c = 0; c < NCHUNK; ++c) {
        {
            PH_ENTER();
            const int lgS = c < 4 ? 11 : 12, bg0 = c < 4 ? 8 * c : 32;
            const float* xin = c < 4 ? KARG(I_XP) + (size_t)c * T * DM : KARG(I_XS);
            row_phase(xin, nullptr, nullptr, nullptr, 0, KARG(I_GMPRE), 1024, 0, WSP(bf16_t, WS_H), WSP(float, WS_MOD), WSP(float, WS_MOD), bg0, lgS, nullptr, nullptr, gw, NGW, lane);
        }
        GSYNC();
        for (int l = 0; l < DEPTH; ++l) {
            {
                PH_ENTER();
                const int S = c < 4 ? 2048 : 4096, lgS = c < 4 ? 11 : 12;
                const bf16_t* WL = WSP(bf16_t, WS_W) + (size_t)l * W_LAYER; bf16_t* Hb = WSP(bf16_t, WS_H);
                pg8::Gemm g{Hb, WL + W_IN, 1024, 1024, 1024, 0, 0}; pg8::StaticOrder so; so.init(T, NZ1, G, bx);
                pg8::EpiIn E{WSP(bf16_t, WS_Z1), WSP(bf16_t, WS_KR), WSP(float, WS_RQ), WSP(float, WS_ROPE), S};
                pg8::gemm_phase<pg8::EpiIn, pg8::StaticOrder, true>(lds, g, so, E);
            }
            {
                PH_ENTER();
                const int S = c < 4 ? 2048 : 4096, lgS = c < 4 ? 11 : 12;
                const bf16_t* WL = WSP(bf16_t, WS_W) + (size_t)l * W_LAYER; bf16_t* Hb = WSP(bf16_t, WS_H);
                pg8::Gemm g2{WL + W_F, Hb, 1024, 1024, 1024, 0, 0}; pg8::StaticOrder so2; so2.init(1024, T, G, bx);
                pg8::EpiUT E2{WSP(bf16_t, WS_UT), S, lgS};
                pg8::gemm_phase<pg8::EpiUT, pg8::StaticOrder, true>(lds, g2, so2, E2);
            }
            GSYNC();
            {
                PH_ENTER();
                const int S = c < 4 ? 2048 : 4096;
                const bf16_t* WL = WSP(bf16_t, WS_W) + (size_t)l * W_LAYER;
                pg8::Gemm g{WSP(bf16_t, WS_Z1), WL + W_QB, 512, NZ1, 512, 0, 0}; pg8::StaticOrder so; so.init(T, NQ, G, bx);
                pg8::EpiQ E{WSP(bf16_t, WS_Q), WSP(float, WS_RQ), WSP(float, WS_ROPE), S};
                pg8::gemm_phase<pg8::EpiQ, pg8::StaticOrder, true>(lds, g, so, E);
            }
            {
                PH_ENTER();
                const bf16_t* WL = WSP(bf16_t, WS_W) + (size_t)l * W_LAYER;
                pg8::Gemm g2{WSP(bf16_t, WS_Z1) + 512, WL + W_KVB, 256, NZ1, 256, 0, 0}; pg8::StaticOrder so2; so2.init(T, NKV, G, bx);
                pg8::EpiKV E2{WSP(bf16_t, WS_KV), WSP(float, WS_RQ)};
                pg8::gemm_phase<pg8::EpiKV, pg8::StaticOrder, true>(lds, g2, so2, E2);
            }
            GSYNC();
            {
                PH_ENTER();
                const int S = c < 4 ? 2048 : 4096, nseq = T / S, nqb = S / 256;
                int d_first, d_step;
                if (G == 256) { d_first = bx < 128 ? -1 : bx - 128; d_step = 128; } else { d_first = bx; d_step = G; }
                if (d_first >= 0) {
                    const bf16_t* Dm = c < 4 ? WSP(bf16_t, WS_D2) : WSP(bf16_t, WS_D4);
                    pg8::Gemm g{Dm, WSP(bf16_t, WS_UT), 2 * S, 2 * S, 2 * S, 0, (size_t)512 * 2 * S}; pg8::DftOrder so{d_first, d_step, nseq * nqb * 2, nqb};
                    pg8::EpiDft E{WSP(bf16_t, WS_FO), S, __builtin_amdgcn_rsqf((float)S * 128.f)};
                    pg8::gemm_phase<pg8::EpiDft, pg8::DftOrder, true>(lds, g, so, E);
                }
            }
            {
                PH_ENTER();
                const int S = c < 4 ? 2048 : 4096, nseq = T / S, nqb = S / 256;
                const int nau = nseq * 8 * nqb;
                int a_first, a_cnt, a_step;
                if (G == 256) { if (bx < 128) { a_first = 3 * bx; a_cnt = 3; } else { a_first = 384 + (bx - 128); a_cnt = 1; } a_step = 1; }
                else { a_first = bx; a_step = G; a_cnt = (nau - bx + G - 1) / G; }
                const bf16_t* Qb = WSP(bf16_t, WS_Q); const bf16_t* KVb = WSP(bf16_t, WS_KV); const bf16_t* KRb = WSP(bf16_t, WS_KR); bf16_t* AO = WSP(bf16_t, WS_AO);
                for (int i = 0; i < a_cnt; ++i) {
                    const int u = a_first + i * a_step; if (u >= nau) break;
                    const int qb = u % nqb, h = (u / nqb) & 7, b = u / (nqb * 8);
                    const size_t r0 = (size_t)b * S;
                    __syncthreads();
                    att::attn_unit(Qb + (r0 + (size_t)qb * 256) * NQ + h * 192, KVb + r0 * NKV + h * 256, KVb + r0 * NKV + h * 256 + 128, KRb + r0 * 64,
                                   AO + (r0 + (size_t)qb * 256) * DM + h * 128, S, (char*)lds_raw);
                }
            }
            GSYNC();
            {
                PH_ENTER();
                const bf16_t* WL = WSP(bf16_t, WS_W) + (size_t)l * W_LAYER;
                pg8::Gemm g{WSP(bf16_t, WS_AO), WL + W_AO, 1024, 1024, 1024, 0, 0}; pg8::StaticOrder so; so.init(T, DM, G, bx);
                pg8::EpiMerge<false> E{WSP(bf16_t, WS_MG), WSP(bf16_t, WS_Z1), 1024};
                pg8::gemm_phase<pg8::EpiMerge<false>, pg8::StaticOrder, true>(lds, g, so, E);
            }
            {
                PH_ENTER();
                const bf16_t* WL = WSP(bf16_t, WS_W) + (size_t)l * W_LAYER;
                pg8::Gemm g2{WSP(bf16_t, WS_FO), WL + W_FOUR, 512, 512, 512, 0, 0}; pg8::StaticOrder so; so.init(T, DM, G, bx);
                pg8::EpiMerge<true> E2{WSP(bf16_t, WS_MG), WSP(bf16_t, WS_Z1), 2048};
                pg8::gemm_phase<pg8::EpiMerge<true>, pg8::StaticOrder, true>(lds, g2, so, E2);
            }
            GSYNC();
            {
                PH_ENTER();
                const bf16_t* WL = WSP(bf16_t, WS_W) + (size_t)l * W_LAYER;
                pg8::Gemm g{WSP(bf16_t, WS_MG), WL + W_OUT, 1024, 1024, 1024, 0, 0}; pg8::StaticOrder so; so.init(T, DM, G, bx);
                pg8::EpiStore E{WSP(bf16_t, WS_Y), DM};
                pg8::gemm_phase<pg8::EpiStore, pg8::StaticOrder, true>(lds, g, so, E);
            }
            GSYNC();
            {
                PH_ENTER();
                const int lgS = c < 4 ? 11 : 12, bg0 = c < 4 ? 8 * c : 32;
                const float* xin = c < 4 ? KARG(I_XP) + (size_t)c * T * DM : KARG(I_XS);
                float* xres = KOUT + (size_t)c * T * DM;
                const float* modl = WSP(float, WS_MOD) + (size_t)l * NB_ALL * 6144;
                row_phase(l == 0 ? xin : xres, xres, WSP(bf16_t, WS_Y), KARG(I_GMPOST) + l * DM, 2048, KARG(I_GFPRE) + l * DM, 4096, 3072, WSP(bf16_t, WS_H), modl, modl, bg0, lgS, nullptr, nullptr, gw, NGW, lane);
            }
            GSYNC();
            {
                PH_ENTER();
                const bf16_t* WL = WSP(bf16_t, WS_W) + (size_t)l * W_LAYER;
                pg8::Gemm g{WSP(bf16_t, WS_H), WL + W_UP, 1024, 1024, 1024, 0, 0}; pg8::StaticOrder so; so.init(T, NUP, G, bx);
                pg8::EpiStore E{WSP(bf16_t, WS_UP), NUP};
                pg8::gemm_phase<pg8::EpiStore, pg8::StaticOrder, true>(lds, g, so, E);
            }
            GSYNC();
            {
                PH_ENTER();
                const int S = c < 4 ? 2048 : 4096;
                conv_phase(WSP(bf16_t, WS_UP), WSP(bf16_t, WS_ACT), KARG(I_WCONV) + (size_t)l * 3 * NUP, KARG(I_BCONV) + (size_t)l * NUP, S, gtid, NT_ALL);
            }
            GSYNC();
            {
                PH_ENTER();
                const bf16_t* WL = WSP(bf16_t, WS_W) + (size_t)l * W_LAYER;
                pg8::Gemm g{WSP(bf16_t, WS_ACT), WL + W_DOWN, DFF, DFF, DFF, 0, 0}; pg8::StaticOrder so; so.init(T, DM, G, bx);
                pg8::EpiStore E{WSP(bf16_t, WS_Y), DM};
                pg8::gemm_phase<pg8::EpiStore, pg8::StaticOrder, true>(lds, g, so, E);
            }
            GSYNC();
            {
                PH_ENTER();
                const int lgS = c < 4 ? 11 : 12, bg0 = c < 4 ? 8 * c : 32;
                float* xres = KOUT + (size_t)c * T * DM;
                const float* modl = WSP(float, WS_MOD) + (size_t)l * NB_ALL * 6144;
                if (l + 1 < DEPTH)
                    row_phase(xres, xres, WSP(bf16_t, WS_Y), KARG(I_GFPOST) + l * DM, 5120, KARG(I_GMPRE) + (l + 1) * DM, 1024, 0, WSP(bf16_t, WS_H), modl, modl + (size_t)NB_ALL * 6144, bg0, lgS, nullptr, nullptr, gw, NGW, lane);
                else
                    row_phase(xres, xres, WSP(bf16_t, WS_Y), KARG(I_GFPOST) + l * DM, 5120, nullptr, 0, 0, nullptr, modl, modl, bg0, lgS, nullptr, nullptr, gw, NGW, lane);
            }
            GSYNC();
        }
    }
}

extern "C" void kernel_launch(void* const* d_in, const int* in_sizes, int n_in, void* d_out, int out_size, void* d_ws, size_t ws_size, hipStream_t stream) {
    static int grid = 0;
    if (grid == 0) {
        if (n_in != 22 || ws_size < WS_END || out_size != 81920 * DM) { fprintf(stderr, "kernel_launch: unexpected shapes (n_in %d, out %d, ws %zu)\n", n_in, out_size, ws_size); grid = -1; return; }
        int dev = 0, cus = 0, per_cu = 0;
        hipGetDevice(&dev); hipDeviceGetAttribute(&cus, hipDeviceAttributeMultiprocessorCount, dev);
        if (hipFuncSetAttribute((const void*)fwd_megakernel, hipFuncAttributeMaxDynamicSharedMemorySize, LDS_BYTES) != hipSuccess) { fprintf(stderr, "hipFuncSetAttribute failed\n"); grid = -1; return; }
        hipOccupancyMaxActiveBlocksPerMultiprocessor(&per_cu, (const void*)fwd_megakernel, 512, LDS_BYTES);
        (void)hipGetLastError();
        if (per_cu < 1) { fprintf(stderr, "occupancy query says %d blocks per CU\n", per_cu); per_cu = 1; }
        grid = cus;
    }
    if (grid < 0) return;
    Args a{};
    for (int i = 0; i < 22; ++i) a.in[i] = (const float*)d_in[i];
    a.out = (float*)d_out; a.ws = (unsigned char*)d_ws;
    if (hipMemsetAsync(d_ws, 0, 16384, stream) != hipSuccess) { fprintf(stderr, "memset failed\n"); return; }
    void* kargs[] = {&a};
    hipError_t e = hipLaunchCooperativeKernel((void*)fwd_megakernel, dim3(grid), dim3(512), kargs, LDS_BYTES, stream);
    if (e != hipSuccess) fprintf(stderr, "cooperative launch failed: %s (grid %d)\n", hipGetErrorString(e), grid);
}
```
